# Optimizing an MI355X kernel written in HIP

```python
import jax, jax.numpy as jnp
from jax import lax
import numpy as np

D_MODEL = 1024
BATCH = 4
SEQ = 4096
DEPTH = 1

PLE_DIM = 256
CONV_WIDTH = D_MODEL // 2
CONV_HEADS = 8
CONV_K = 3
SGU_WIDTH = D_MODEL // 2
SGU_HEADS = 8
SGU_HEAD_DIM = SGU_WIDTH // SGU_HEADS
CHUNK = 128
MIX_WIDTH = CONV_WIDTH + SGU_WIDTH
IN_PROJ_WIDTH = 3 * CONV_WIDTH + 2 * SGU_WIDTH
N_GROUPS = 4
EXPERTS_PER_GROUP = 8
TOP_K_INNER = 2
D_EXPERT = D_MODEL // 2
EPS = 1e-6

kernel_name = "hymba_conv_sgu_hmoe_block"


def rmsnorm(x, g):
    xf = x.astype(jnp.float32)
    y = xf * lax.rsqrt(jnp.mean(xf * xf, axis=-1, keepdims=True) + EPS)
    return (y * g.astype(jnp.float32)).astype(x.dtype)


def layernorm(x, g):
    xf = x.astype(jnp.float32)
    mu = jnp.mean(xf, axis=-1, keepdims=True)
    xc = xf - mu
    y = xc * lax.rsqrt(jnp.mean(xc * xc, axis=-1, keepdims=True) + EPS)
    return (y * g.astype(jnp.float32)).astype(x.dtype)


def short_conv_mixer(b_gate, c_gate, x_in, w_conv):
    seq = x_in.shape[1]
    z = c_gate * x_in
    zp = jnp.pad(z, ((0, 0), (CONV_K - 1, 0), (0, 0)))
    conv = sum(zp[:, k:k + seq, :] * w_conv[k] for k in range(CONV_K))
    return b_gate * conv


def sgu_mixer(u, v, g_sgu, w_spatial, b_spatial):
    bsz, seq, _ = v.shape
    v = layernorm(v, g_sgu)
    vc = v.reshape(bsz, seq // CHUNK, CHUNK, SGU_HEADS, SGU_HEAD_DIM)
    causal = jnp.tril(jnp.ones((CHUNK, CHUNK), dtype=bool))
    ws = jnp.where(causal[None], w_spatial, jnp.zeros_like(w_spatial))
    mixed = jnp.einsum('hts,bcshd->bcthd', ws, vc) + b_spatial.T[None, None, :, :, None]
    return u * mixed.reshape(bsz, seq, SGU_WIDTH)


def hierarchical_moe(h, w_group, b_group, w_router, b_router, w_gate, w_up, w_down):
    bsz, seq, d = h.shape
    t = h.reshape(bsz * seq, d)
    g_logits = (t @ w_group).astype(jnp.float32) + b_group.astype(jnp.float32)
    g_prob = jax.nn.softmax(g_logits, axis=-1)
    g_w, g_idx = lax.top_k(g_prob, 1)
    e_logits = jnp.einsum('td,gde->tge', t, w_router).astype(jnp.float32) + b_router.astype(jnp.float32)
    e_sel = jnp.take_along_axis(e_logits, g_idx[:, :, None], axis=1)[:, 0]
    e_val, e_idx = lax.top_k(e_sel, TOP_K_INNER)
    e_w = jax.nn.softmax(e_val, axis=-1) * g_w
    inner = jnp.sum(jax.nn.one_hot(e_idx, EXPERTS_PER_GROUP, dtype=jnp.float32) * e_w[..., None], axis=1)
    comb = (jax.nn.one_hot(g_idx[:, 0], N_GROUPS, dtype=jnp.float32)[:, :, None]
            * inner[:, None, :]).astype(h.dtype)
    y = jnp.zeros_like(t)
    for g in range(N_GROUPS):
        a = jnp.einsum('td,edf->tef', t, w_gate[g])
        b = jnp.einsum('td,edf->tef', t, w_up[g])
        hid = jax.nn.silu(a) * b * comb[:, g, :, None]
        y = y + jnp.einsum('tef,efd->td', hid, w_down[g])
    return y.reshape(bsz, seq, d)


def setup_inputs(seed: int = 0) -> dict:
    key = jax.random.key(seed)
    ks = jax.random.split(key, 24)
    f32 = jnp.float32
    n = lambda k, shape, scale: jax.random.normal(k, shape, f32) * scale
    gain = lambda k, shape: 1.0 + 0.05 * jax.random.normal(k, shape, f32)
    L, G, E = DEPTH, N_GROUPS, EXPERTS_PER_GROUP
    return {
        "x": n(ks[0], (BATCH, SEQ, D_MODEL), 1.0),
        "p": n(ks[1], (DEPTH, BATCH, SEQ, PLE_DIM), 1.0),
        "g_mix": gain(ks[2], (L, D_MODEL)),
        "w_in": n(ks[3], (L, D_MODEL, IN_PROJ_WIDTH), D_MODEL ** -0.5),
        "w_conv": n(ks[4], (L, CONV_K, CONV_WIDTH), CONV_K ** -0.5),
        "g_sgu": gain(ks[5], (L, SGU_WIDTH)),
        "w_spatial": n(ks[6], (L, SGU_HEADS, CHUNK, CHUNK), CHUNK ** -0.5),
        "b_spatial": 1.0 + n(ks[7], (L, SGU_HEADS, CHUNK), 0.1),
        "w_out": n(ks[8], (L, MIX_WIDTH, D_MODEL), MIX_WIDTH ** -0.5),
        "g_ffn": gain(ks[9], (L, D_MODEL)),
        "w_group": n(ks[10], (L, D_MODEL, G), D_MODEL ** -0.5),
        "b_group": n(ks[11], (L, G), 0.01),
        "w_router": n(ks[12], (L, G, D_MODEL, E), D_MODEL ** -0.5),
        "b_router": n(ks[13], (L, G, E), 0.01),
        "w_gate": n(ks[14], (L, G, E, D_MODEL, D_EXPERT), D_MODEL ** -0.5),
        "w_up": n(ks[15], (L, G, E, D_MODEL, D_EXPERT), D_MODEL ** -0.5),
        "w_down": n(ks[16], (L, G, E, D_EXPERT, D_MODEL), D_EXPERT ** -0.5),
        "g_ple": gain(ks[17], (L, D_MODEL)),
        "w_ple_gate": n(ks[18], (L, D_MODEL, D_MODEL), D_MODEL ** -0.5),
        "w_ple_proj": n(ks[19], (L, PLE_DIM, D_MODEL), PLE_DIM ** -0.5),
        "g_final": gain(ks[20], (D_MODEL,)),
    }


def reference(x, p, g_mix, w_in, w_conv, g_sgu, w_spatial, b_spatial, w_out, g_ffn,
              w_group, b_group, w_router, b_router, w_gate, w_up, w_down,
              g_ple, w_ple_gate, w_ple_proj, g_final):
    splits = [CONV_WIDTH, 2 * CONV_WIDTH, 3 * CONV_WIDTH, 3 * CONV_WIDTH + SGU_WIDTH]
    for i in range(DEPTH):
        h = rmsnorm(x, g_mix[i])
        z = h @ w_in[i]
        b_gate, c_gate, x_in, u, v = jnp.split(z, splits, axis=-1)
        y_conv = short_conv_mixer(b_gate, c_gate, x_in, w_conv[i])
        y_sgu = sgu_mixer(jax.nn.gelu(u), jax.nn.gelu(v), g_sgu[i],
                          w_spatial[i], b_spatial[i])
        x = x + jnp.concatenate([y_conv, y_sgu], axis=-1) @ w_out[i]
        x = x + hierarchical_moe(rmsnorm(x, g_ffn[i]), w_group[i], b_group[i], w_router[i],
                                 b_router[i], w_gate[i], w_up[i], w_down[i])
        gate = jax.nn.sigmoid(rmsnorm(x, g_ple[i]) @ w_ple_gate[i])
        x = x + gate * (p[i] @ w_ple_proj[i])
    return rmsnorm(x, g_final)
```

```cpp
#include <hip/hip_runtime.h>
#include <cstdio>
#include <cstdint>

#ifndef MK_ONE_LAUNCH
#define MK_ONE_LAUNCH 1
#endif

#define GAS __attribute__((address_space(1)))
#define LAS __attribute__((address_space(3)))
typedef unsigned short bf16;
typedef short bf16x8 __attribute__((ext_vector_type(8)));
typedef float f32x4 __attribute__((ext_vector_type(4)));
typedef float f32x2 __attribute__((ext_vector_type(2)));
typedef unsigned u32x4 __attribute__((ext_vector_type(4)));
typedef unsigned u32x2 __attribute__((ext_vector_type(2)));

constexpr int T = 16384, D = 1024, SEQ = 4096, NIN = 2560, ZW = 2048, CH = 128, NE = 32, FE = 512, PLE = 256, CAP = 16384;
constexpr float EPS = 1e-6f;
constexpr int NWAVES = 8, NTHR = 512;

constexpr size_t MiB = 1u << 20;
constexpr size_t WS_CTL = 0, CTL_ZERO_BYTES = 64 * 1024;
constexpr size_t WS_WIN = 1 * MiB;
constexpr size_t WS_WOUT = 6 * MiB;
constexpr size_t WS_WPG = 8 * MiB;
constexpr size_t WS_WPP = 10 * MiB;
constexpr size_t WS_WR = 10 * MiB + 512 * 1024;
constexpr size_t WS_RSTD = 10 * MiB + 768 * 1024;
constexpr size_t WS_PINFO = 11 * MiB;
constexpr size_t WS_PBF = 19 * MiB;
constexpr size_t WS_WGU = 28 * MiB;
constexpr size_t WS_WDN = 92 * MiB;
constexpr size_t WS_XN = 124 * MiB;
constexpr size_t WS_Z = 156 * MiB;
constexpr size_t WS_Y = 220 * MiB;
constexpr size_t WS_END = 253 * MiB;
constexpr int CW_CNT = 64;
constexpr int CW_BAR = 4096;

constexpr int RING_BYTES = 131072;
constexpr int LDSCTL_OFF = RING_BYTES;
constexpr int TAB_OFF = RING_BYTES + 1024;
constexpr int LDS_BYTES = 147456;

#define LDS_WAIT() asm volatile("s_waitcnt lgkmcnt(0)" ::: "memory")
#define VM_WAIT() asm volatile("s_waitcnt vmcnt(0)" ::: "memory")

__device__ __forceinline__ unsigned cvt_pk_bf16(float lo, float hi) { unsigned r; asm volatile("v_cvt_pk_bf16_f32 %0, %1, %2" : "=v"(r) : "v"(lo), "v"(hi)); return r; }
__device__ __forceinline__ float bf_lo(unsigned u) { return __builtin_bit_cast(float, u << 16); }
__device__ __forceinline__ float bf_hi(unsigned u) { return __builtin_bit_cast(float, u & 0xffff0000u); }
__device__ __forceinline__ float fast_rcp(float x) { return __builtin_amdgcn_rcpf(x); }
__device__ __forceinline__ float fast_exp(float x) { return __builtin_amdgcn_exp2f(x * 1.4426950408889634f); }
__device__ __forceinline__ float sigmoidf_(float x) { return fast_rcp(1.0f + fast_exp(-x)); }
__device__ __forceinline__ float gelu_tanh(float v) { const float y = 1.5957691216057308f * (v + 0.044715f * v * v * v); return v * fast_rcp(1.0f + fast_exp(-y)); }
__device__ __forceinline__ float wave_sum(float v) {
#pragma unroll
    for (int o = 1; o < 64; o <<= 1) v += __shfl_xor(v, o);
    return v;
}

namespace pg8 {
constexpr int BM = 256, BK = 64, HALF = 128, HTB = HALF * BK * 2, STAGE_BYTES = 8 * HTB, NXCD = 8, WGM = 8;
__host__ __device__ __forceinline__ int lds_byte(int r, int c) { const int st = (r >> 4) * 2 + (c >> 5), rr = r & 15, cc = c & 31, ob = rr * 64 + cc * 2; return st * 1024 + (ob ^ (((ob >> 9) & 1) << 5)); }
__host__ __device__ __forceinline__ void stage_rc(int b, int& R, int& C) { const int st = b / 1024, sb = b % 1024, swz = sb ^ (((sb >> 9) & 1) << 5); R = (st >> 1) * 16 + swz / 64; C = (st & 1) * 32 + (swz % 64) / 2; }
__host__ __device__ __forceinline__ int perm32(int rho) { const int n = rho >> 4, i = rho & 15; return 8 * (i >> 2) + 4 * n + (i & 3); }

struct Unit { int pm, pn, e, rows, base; };

struct StaticOrder {
    int nM, nN, nwg, G, c;
    __device__ void init(int M, int N, int G_, int c_) { nM = M / BM; nN = N / BM; nwg = nM * nN; G = G_; c = c_; }
    __device__ bool next(int i, Unit& u) const {
        const long L = (long)i * G + c; if (L >= nwg) return false;
        int wgid = (int)L; { const int q = nwg / NXCD, r = nwg % NXCD, xcd = wgid % NXCD, off = wgid / NXCD; wgid = (xcd < r ? xcd * (q + 1) : r * (q + 1) + (xcd - r) * q) + off; }
        const int nig = WGM * nN, gid = wgid / nig, fm = gid * WGM, gsz = (nM - fm) < WGM ? (nM - fm) : WGM;
        u.pm = fm + ((wgid % nig) % gsz); u.pn = (wgid % nig) / gsz; u.e = 0; u.rows = BM; u.base = u.pm * BM; return true;
    }
};

template <class P, bool ALIGN_EPI>
__device__ __forceinline__ void gemm_phase(LAS unsigned char* lds, const P& p) {
    const int tid = threadIdx.x, wid = __builtin_amdgcn_readfirstlane(tid >> 6), lane = tid & 63, wr = wid >> 2, wc = wid & 3, fr = lane & 15, fq = lane >> 4;
    const int K = p.K, nt = K / BK;
    int Rr[2], Cc[2]; unsigned voffB[2];
#pragma unroll
    for (int i = 0; i < 2; ++i) { stage_rc(tid * 16 + i * 8192, Rr[i], Cc[i]); const int Rb = P::PERM ? ((Rr[i] & ~31) + perm32(Rr[i] & 31)) : Rr[i]; voffB[i] = (unsigned)(Rb * K + Cc[i]) * 2u; }
    const size_t kstep = (size_t)(BK * 2), hstep = (size_t)HALF * K * 2;
    const unsigned ldsw = (unsigned)wid * 1024u;
    const int aoff = lds_byte(wr * 64 + fr, fq * 8), boff = lds_byte(wc * 32 + fr, fq * 8);
#define PG8_SA(b, h) (((b) * 2 + (h)) * HTB)
#define PG8_SB(b, h) ((4 + (b) * 2 + (h)) * HTB)
#define PG8_STAGE(bufoff, gbase, voff) do { _Pragma("unroll") for (int _i = 0; _i < 2; ++_i) \
        __builtin_amdgcn_global_load_lds((const unsigned*)((const char*)(gbase) + (voff)[_i]), (LAS unsigned*)(lds + (bufoff) + ldsw + _i * 8192), 16, 0, 0); } while (0)
#define PG8_LDA(dst, b, h) do { _Pragma("unroll") for (int m = 0; m < 4; ++m) _Pragma("unroll") for (int k = 0; k < 2; ++k) dst[m][k] = *(const LAS bf16x8*)(lds + PG8_SA(b, h) + aoff + m * 2048 + k * 1024); } while (0)
#define PG8_LDB(dst, b, h) do { _Pragma("unroll") for (int n = 0; n < 2; ++n) _Pragma("unroll") for (int k = 0; k < 2; ++k) dst[n][k] = *(const LAS bf16x8*)(lds + PG8_SB(b, h) + boff + n * 2048 + k * 1024); } while (0)
#define PG8_MMA(ai, bj, At, Bt) do { __builtin_amdgcn_s_setprio(1); _Pragma("unroll") for (int m = 0; m < 4; ++m) _Pragma("unroll") for (int n = 0; n < 2; ++n) _Pragma("unroll") for (int k = 0; k < 2; ++k) \
        acc[ai][bj][m][n] = __builtin_amdgcn_mfma_f32_16x16x32_bf16(Bt[n][k], At[m][k], acc[ai][bj][m][n], 0, 0, 0); __builtin_amdgcn_s_setprio(0); } while (0)
#define PG8_WAIT_V(n) asm volatile("s_waitcnt vmcnt(" #n ")" ::: "memory")
#define PG8_WAIT_L(n) asm volatile("s_waitcnt lgkmcnt(" #n ")" ::: "memory")
#define PG8_BAR __builtin_amdgcn_s_barrier()
#define PG8_SCHED __builtin_amdgcn_sched_barrier(0)
    Unit cur, nxt; int ui = 0;
    if (!p.next(0, cur)) return;
    f32x4 acc[2][2][4][2];
#pragma unroll
    for (int a = 0; a < 2; ++a)
#pragma unroll
        for (int b = 0; b < 2; ++b)
#pragma unroll
            for (int m = 0; m < 4; ++m)
#pragma unroll
                for (int n = 0; n < 2; ++n) acc[a][b][m][n] = (f32x4){0.f, 0.f, 0.f, 0.f};
    bf16x8 At[4][2], B0[2][2], B1[2][2];
    unsigned vAc[2][2], vAn[2][2];
    p.a_rows(cur, vAc, Rr, Cc);
    const char* gA = (const char*)p.A;
    const char* cB = p.b_base(cur);
    PG8_STAGE(PG8_SB(0, 0), cB, voffB); PG8_STAGE(PG8_SB(0, 1), cB + hstep, voffB); PG8_STAGE(PG8_SA(0, 0), gA, vAc[0]); PG8_STAGE(PG8_SA(0, 1), gA, vAc[1]);
    if (wr == 1) PG8_BAR;
    PG8_WAIT_V(2); PG8_BAR;
    PG8_STAGE(PG8_SB(1, 0), cB + kstep, voffB); PG8_STAGE(PG8_SA(1, 0), gA + kstep, vAc[0]); PG8_STAGE(PG8_SB(1, 1), cB + hstep + kstep, voffB);
    PG8_WAIT_V(6); PG8_BAR;
    for (;;) {
        const bool has_next = p.next(ui + 1, nxt);
        const char* nB = has_next ? p.b_base(nxt) : cB;
        if (has_next) p.a_rows(nxt, vAn, Rr, Cc);
        else { vAn[0][0] = vAc[0][0]; vAn[0][1] = vAc[0][1]; vAn[1][0] = vAc[1][0]; vAn[1][1] = vAc[1][1]; }
        for (int t = 0; t < nt; t += 2) {
            const bool last = (t == nt - 2);
            const char* a1 = gA + (size_t)(t + 1) * kstep;
            const char* a2 = last ? gA : gA + (size_t)(t + 2) * kstep; const char* b2 = last ? nB : cB + (size_t)(t + 2) * kstep;
            const char* a3 = a2 + kstep; const char* b3 = b2 + kstep;
            unsigned s0[2], s1[2];
            s0[0] = last ? vAn[0][0] : vAc[0][0]; s0[1] = last ? vAn[0][1] : vAc[0][1]; s1[0] = last ? vAn[1][0] : vAc[1][0]; s1[1] = last ? vAn[1][1] : vAc[1][1];
            PG8_LDB(B0, 0, 0); PG8_LDB(B1, 0, 1); PG8_SCHED; PG8_LDA(At, 0, 0); PG8_STAGE(PG8_SA(1, 1), a1, vAc[1]);
            PG8_WAIT_V(8); PG8_WAIT_L(0); PG8_BAR; PG8_MMA(0, 0, At, B0); PG8_MMA(0, 1, At, B1); PG8_BAR; PG8_SCHED;
            PG8_LDA(At, 0, 1); PG8_STAGE(PG8_SB(0, 0), b2, voffB); PG8_STAGE(PG8_SB(0, 1), b2 + hstep, voffB); PG8_STAGE(PG8_SA(0, 0), a2, s0);
            PG8_WAIT_V(8); PG8_WAIT_L(0); PG8_BAR; PG8_MMA(1, 0, At, B0); PG8_MMA(1, 1, At, B1); PG8_BAR; PG8_SCHED;
            PG8_LDB(B0, 1, 0); PG8_LDB(B1, 1, 1); PG8_SCHED; PG8_LDA(At, 1, 0); PG8_STAGE(PG8_SA(0, 1), a2, s1);
            PG8_WAIT_V(8); PG8_WAIT_L(0); PG8_BAR; PG8_MMA(0, 0, At, B0); PG8_MMA(0, 1, At, B1); PG8_BAR; PG8_SCHED;
            PG8_LDA(At, 1, 1); PG8_STAGE(PG8_SB(1, 0), b3, voffB); PG8_STAGE(PG8_SB(1, 1), b3 + hstep, voffB); PG8_STAGE(PG8_SA(1, 0), a3, s0);
            PG8_WAIT_V(8); PG8_WAIT_L(0); PG8_BAR; PG8_MMA(1, 0, At, B0); PG8_MMA(1, 1, At, B1); PG8_BAR; PG8_SCHED;
        }
        if constexpr (ALIGN_EPI) { if (wr == 0) PG8_BAR; }
        p.epi(acc, cur, wr, wc, fr, fq);
        if (!has_next) break;
#pragma unroll
        for (int a = 0; a < 2; ++a)
#pragma unroll
            for (int b = 0; b < 2; ++b)
#pragma unroll
                for (int m = 0; m < 4; ++m)
#pragma unroll
                    for (int n = 0; n < 2; ++n) acc[a][b][m][n] = (f32x4){0.f, 0.f, 0.f, 0.f};
        cur = nxt; cB = nB; ++ui;
        vAc[0][0] = vAn[0][0]; vAc[0][1] = vAn[0][1]; vAc[1][0] = vAn[1][0]; vAc[1][1] = vAn[1][1];
        if constexpr (ALIGN_EPI) { if (wr == 1) PG8_BAR; }
    }
    PG8_WAIT_V(0);
    if constexpr (!ALIGN_EPI) { if (wr == 0) PG8_BAR; }
    PG8_BAR;
#undef PG8_SA
#undef PG8_SB
#undef PG8_STAGE
#undef PG8_LDA
#undef PG8_LDB
#undef PG8_MMA
#undef PG8_WAIT_V
#undef PG8_WAIT_L
#undef PG8_BAR
#undef PG8_SCHED
}
}
using pg8::Unit;

#define XB_TMO      128
#define XB_XCNT(j)  (256  + 64 * (j))
#define XB_XSUB(j)  (1280 + 64 * (j))
#define XB_XGEN(j)  (2304 + 64 * (j))
#define XB_TOP      3328
#define XB_TOPGEN   3392
#define XCD_BAR_WORDS 3456
#define XB_SPIN_CAP (1u << 18)
__device__ __forceinline__ unsigned xb_ld(unsigned* p)              { return __hip_atomic_load(p, __ATOMIC_RELAXED, __HIP_MEMORY_SCOPE_AGENT); }
__device__ __forceinline__ unsigned xb_add(unsigned* p, unsigned v) { return __hip_atomic_fetch_add(p, v, __ATOMIC_RELAXED, __HIP_MEMORY_SCOPE_AGENT); }
__device__ __forceinline__ unsigned xb_xcc_id() { return (unsigned)__builtin_amdgcn_s_getreg((3 << 11) | 20) & 0xFu; }
#define XB_SPIN(cond, bar) do { unsigned _sp = 0; while (cond) { __builtin_amdgcn_s_sleep(1); \
    if ((++_sp & 255u) == 0u) { if (xb_ld(&(bar)[XB_TMO])) break; if (_sp > XB_SPIN_CAP) { atomicAdd(&(bar)[XB_TMO], 1u); break; } } } } while (0)
struct XcdBarrier { unsigned* bar; unsigned x; volatile LAS unsigned* st; };
__device__ __forceinline__ XcdBarrier xcd_barrier_post(unsigned* bar, volatile LAS unsigned* st) {
    XcdBarrier b; b.bar = bar; b.x = xb_xcc_id(); b.st = st;
    if (threadIdx.x == 0) (void)xb_add(&bar[XB_XCNT(b.x)], 1u);
    return b;
}
__device__ __forceinline__ void xcd_barrier_complete(unsigned* bar, unsigned x, unsigned& nloc, unsigned& nx) {
    const unsigned G = gridDim.x * gridDim.y * gridDim.z;
    unsigned sum, cnt, mine, sp = 0u;
    for (;;) {
        sum = 0u; cnt = 0u; mine = 0u;
#pragma unroll
        for (unsigned j = 0; j < 16; ++j) { const unsigned c = xb_ld(&bar[XB_XCNT(j)]); sum += c; cnt += (c > 0u) ? 1u : 0u; mine = (j == x) ? c : mine; }
        if (sum == G) break;
        __builtin_amdgcn_s_sleep(1);
        if ((++sp & 255u) == 0u) { if (xb_ld(&bar[XB_TMO])) break; if (sp > XB_SPIN_CAP) { atomicAdd(&bar[XB_TMO], 1u); break; } }
    }
    nloc = mine > 0u ? mine : 1u; nx = cnt > 0u ? cnt : 1u;
}
__device__ __forceinline__ void xcd_barrier(const XcdBarrier& b) {
    asm volatile("s_waitcnt vmcnt(0)" ::: "memory");
    __syncthreads();
    if (threadIdx.x == 0) {
        unsigned* bar = b.bar;
        __builtin_amdgcn_s_waitcnt(0);
        unsigned nloc = b.st[0], nx = b.st[1];
        if (nloc == 0u) { xcd_barrier_complete(bar, b.x, nloc, nx); b.st[0] = nloc; b.st[1] = nx; }
        const unsigned old = xb_add(&bar[XB_XSUB(b.x)], 1u);
        const unsigned gen = old / nloc;
        if (old + 1u == (gen + 1u) * nloc) {
            __builtin_amdgcn_fence(__ATOMIC_RELEASE, "agent");
            asm volatile("s_waitcnt vmcnt(0)" ::: "memory");
            const unsigned og = xb_add(&bar[XB_TOP], 1u);
            const unsigned tg = og / nx;
            if (og + 1u == (tg + 1u) * nx) xb_add(&bar[XB_TOPGEN], 1u);
            else XB_SPIN(xb_ld(&bar[XB_TOPGEN]) == tg, bar);
            __builtin_amdgcn_fence(__ATOMIC_ACQUIRE, "agent");
            xb_add(&bar[XB_XGEN(b.x)], 1u);
            asm volatile("s_waitcnt vmcnt(0)" ::: "memory");
        } else {
            XB_SPIN(xb_ld(&bar[XB_XGEN(b.x)]) == gen, bar);
            __builtin_amdgcn_fence(__ATOMIC_ACQUIRE, "agent");
            asm volatile("s_waitcnt vmcnt(0)" ::: "memory");
        }
    }
    __syncthreads();
}

struct Frame {
    LAS unsigned char* lds;
    unsigned* ctl;
    int tid, lane, wave, vcu, G;
    const float* in[21]; float* out; unsigned char* ws;
};
struct PInfo { int dest; float w; float rstd; int pad; };

__device__ __forceinline__ int map_row(int mode, int n) {
    if (mode == 1) { if (n < 512 || n >= 1536) return n; if (n < 1024) { const int j = n - 512; return 512 + (j >> 7) * 256 + (j & 127); } const int j = n - 1024; return 512 + (j >> 7) * 256 + 128 + (j & 127); }
    if (mode == 2) return (n >> 7) * 256 + (n & 127);
    if (mode == 3) return (n >> 7) * 256 + 128 + (n & 127);
    return n;
}
__device__ __forceinline__ void p0_transpose_item(const float* W, int K, int N, bf16* WT, int mode, const float* gs, LAS float* scr, int item, int lane) {
    const int nblk = N / 32, kb = item / nblk, nb = item % nblk, k0 = 64 * kb, n0 = 32 * nb;
#pragma unroll 8
    for (int i = 0; i < 32; ++i) { const int kk = 2 * i + (lane >> 5); float v = W[(size_t)(k0 + kk) * N + n0 + (lane & 31)]; if (gs) v *= gs[k0 + kk]; scr[kk * 33 + (lane & 31)] = v; }
    LDS_WAIT(); asm volatile("" ::: "memory");
    const int c = lane & 7;
#pragma unroll
    for (int j = 0; j < 4; ++j) { const int n = (lane >> 3) + 8 * j; const LAS float* s = scr + (8 * c) * 33 + n;
        u32x4 o; o.x = cvt_pk_bf16(s[0 * 33], s[1 * 33]); o.y = cvt_pk_bf16(s[2 * 33], s[3 * 33]); o.z = cvt_pk_bf16(s[4 * 33], s[5 * 33]); o.w = cvt_pk_bf16(s[6 * 33], s[7 * 33]);
        *(u32x4*)(WT + (size_t)map_row(mode, n0 + n) * K + k0 + 8 * c) = o; }
    LDS_WAIT(); asm volatile("" ::: "memory");
}
__device__ __forceinline__ void p0_prologue(Frame& F) {
    LAS float* scr = (LAS float*)(F.lds + F.wave * 16384);
    const int gw = F.vcu * NWAVES + F.wave, NGW = F.G * NWAVES;
    unsigned char* ws = F.ws;
    constexpr int I_IN = 16 * 80, I_OUT = 16 * 32, I_G = 32 * 256, I_U = 32 * 256, I_D = 32 * 256, I_PG = 16 * 32, I_PP = 4 * 32;
    constexpr int NITEMS = I_IN + I_OUT + I_G + I_U + I_D + I_PG + I_PP;
    for (int it = gw; it < NITEMS; it += NGW) {
        int r = it;
        if (r < I_G) { const int e = r >> 8; p0_transpose_item(F.in[14] + (size_t)e * D * FE, D, FE, (bf16*)(ws + WS_WGU) + (size_t)e * 1024 * 1024, 2, F.in[9], scr, r & 255, F.lane); continue; } r -= I_G;
        if (r < I_U) { const int e = r >> 8; p0_transpose_item(F.in[15] + (size_t)e * D * FE, D, FE, (bf16*)(ws + WS_WGU) + (size_t)e * 1024 * 1024, 3, F.in[9], scr, r & 255, F.lane); continue; } r -= I_U;
        if (r < I_D) { const int e = r >> 8; p0_transpose_item(F.in[16] + (size_t)e * FE * D, FE, D, (bf16*)(ws + WS_WDN) + (size_t)e * 1024 * 512, 0, nullptr, scr, r & 255, F.lane); continue; } r -= I_D;
        if (r < I_IN) { p0_transpose_item(F.in[3], D, NIN, (bf16*)(ws + WS_WIN), 1, nullptr, scr, r, F.lane); continue; } r -= I_IN;
        if (r < I_OUT) { p0_transpose_item(F.in[8], D, D, (bf16*)(ws + WS_WOUT), 0, nullptr, scr, r, F.lane); continue; } r -= I_OUT;
        if (r < I_PG) { p0_transpose_item(F.in[18], D, D, (bf16*)(ws + WS_WPG), 0, F.in[17], scr, r, F.lane); continue; } r -= I_PG;
        p0_transpose_item(F.in[19], PLE, D, (bf16*)(ws + WS_WPP), 0, nullptr, scr, r, F.lane);
    }
    {
        const float* x = F.in[0]; const float* g = F.in[2]; bf16* XN = (bf16*)(ws + WS_XN);
        f32x4 gv[4];
#pragma unroll
        for (int j = 0; j < 4; ++j) gv[j] = *((const f32x4*)g + F.lane + 64 * j);
        for (int m = gw; m < T; m += NGW) {
            const f32x4* xr = (const f32x4*)(x + (size_t)m * D) + F.lane;
            f32x4 v[4]; float s = 0.f;
#pragma unroll
            for (int j = 0; j < 4; ++j) { v[j] = xr[64 * j]; s += (v[j].x * v[j].x + v[j].y * v[j].y) + (v[j].z * v[j].z + v[j].w * v[j].w); }
            const float rstd = 1.0f / sqrtf(wave_sum(s) * (1.f / D) + EPS);
            u32x2* o8 = (u32x2*)(XN + (size_t)m * D) + F.lane;
#pragma unroll
            for (int j = 0; j < 4; ++j) { const f32x4 y = v[j] * rstd * gv[j]; u32x2 w; w.x = cvt_pk_bf16(y.x, y.y); w.y = cvt_pk_bf16(y.z, y.w); o8[64 * j] = w; }
        }
    }
    {
        const float* p = F.in[1]; bf16* PB = (bf16*)(ws + WS_PBF);
        const int gt = F.vcu * NTHR + F.tid, NGT = F.G * NTHR;
        for (int i = gt; i < T * PLE / 8; i += NGT) { const f32x4 a = *((const f32x4*)p + 2 * i), b = *((const f32x4*)p + 2 * i + 1);
            u32x4 w; w.x = cvt_pk_bf16(a.x, a.y); w.y = cvt_pk_bf16(a.z, a.w); w.z = cvt_pk_bf16(b.x, b.y); w.w = cvt_pk_bf16(b.z, b.w); *((u32x4*)PB + i) = w; }
        bf16* WRH = (bf16*)(ws + WS_WR); bf16* WRL = WRH + 48 * 1024;
        const float* gf = F.in[9]; const float* wg = F.in[10]; const float* wrt = F.in[12];
        for (int i = gt; i < 48 * 1024; i += NGT) { const int o = i >> 10, k = i & 1023; float v = 0.f;
            if (o < 4) v = wg[k * 4 + o]; else if (o < 36) { const int gg = (o - 4) >> 3, e = (o - 4) & 7; v = wrt[((size_t)gg * D + k) * 8 + e]; }
            v *= gf[k]; const unsigned h = cvt_pk_bf16(v, 0.f) & 0xffffu; const float hf = bf_lo(h); const unsigned l = cvt_pk_bf16(v - hf, 0.f) & 0xffffu;
            WRH[i] = (bf16)h; WRL[i] = (bf16)l; }
    }
}

__device__ __forceinline__ void dense_rows(const Unit& u, int K, unsigned (&vA)[2][2], const int (&R)[2], const int (&C)[2]) {
#pragma unroll
    for (int h = 0; h < 2; ++h)
#pragma unroll
        for (int i = 0; i < 2; ++i) vA[h][i] = (unsigned)((u.base + h * 128 + R[i]) * K + C[i]) * 2u;
}
struct ProbInProj {
    static constexpr bool PERM = true;
    const bf16* A; const bf16* Bt; int K; bf16* Z; pg8::StaticOrder S;
    __device__ bool next(int i, Unit& u) const { return S.next(i, u); }
    __device__ const char* b_base(const Unit& u) const { return (const char*)Bt + (size_t)u.pn * 256 * K * 2; }
    __device__ void a_rows(const Unit& u, unsigned (&vA)[2][2], const int (&R)[2], const int (&C)[2]) const { dense_rows(u, K, vA, R, C); }
    __device__ __forceinline__ void epi(const f32x4 (&acc)[2][2][4][2], const Unit& u, int wr, int wc, int fr, int fq) const {
        const int row0 = u.pm * 256 + wr * 64 + fr, pn = u.pn;
        if (pn >= 2 && pn < 6) {
            const int col0 = 512 + (pn - 2) * 128 + wc * 32 + 8 * fq;
#pragma unroll
            for (int ai = 0; ai < 2; ++ai)
#pragma unroll
                for (int m = 0; m < 4; ++m) { bf16* rowp = Z + (size_t)(row0 + ai * 128 + m * 16) * ZW + col0;
                    const f32x4 v0 = acc[ai][0][m][0] * acc[ai][1][m][0], v1 = acc[ai][0][m][1] * acc[ai][1][m][1];
                    u32x4 w; w.x = cvt_pk_bf16(v0[0], v0[1]); w.y = cvt_pk_bf16(v0[2], v0[3]); w.z = cvt_pk_bf16(v1[0], v1[1]); w.w = cvt_pk_bf16(v1[2], v1[3]);
                    *(u32x4*)rowp = w; }
        } else {
            const bool act = pn >= 6; const int colt = pn < 2 ? pn * 256 : 1024 + (pn - 6) * 256; const int col0 = colt + wc * 32 + 8 * fq;
#pragma unroll
            for (int ai = 0; ai < 2; ++ai)
#pragma unroll
                for (int m = 0; m < 4; ++m) { bf16* rowp = Z + (size_t)(row0 + ai * 128 + m * 16) * ZW + col0;
#pragma unroll
                    for (int bj = 0; bj < 2; ++bj) { f32x4 v0 = acc[ai][bj][m][0], v1 = acc[ai][bj][m][1];
                        if (act) {
#pragma unroll
                            for (int i = 0; i < 4; ++i) { v0[i] = gelu_tanh(v0[i]); v1[i] = gelu_tanh(v1[i]); } }
                        u32x4 w; w.x = cvt_pk_bf16(v0[0], v0[1]); w.y = cvt_pk_bf16(v0[2], v0[3]); w.z = cvt_pk_bf16(v1[0], v1[1]); w.w = cvt_pk_bf16(v1[2], v1[3]);
                        *(u32x4*)(rowp + bj * 128) = w; } }
        }
    }
};
struct ProbOutProj {
    static constexpr bool PERM = false;
    const bf16* A; const bf16* Bt; int K; const float* x; float* out; pg8::StaticOrder S;
    __device__ bool next(int i, Unit& u) const { return S.next(i, u); }
    __device__ const char* b_base(const Unit& u) const { return (const char*)Bt + (size_t)u.pn * 256 * K * 2; }
    __device__ void a_rows(const Unit& u, unsigned (&vA)[2][2], const int (&R)[2], const int (&C)[2]) const { dense_rows(u, K, vA, R, C); }
    __device__ __forceinline__ void epi(const f32x4 (&acc)[2][2][4][2], const Unit& u, int wr, int wc, int fr, int fq) const {
        const int row0 = u.pm * 256 + wr * 64 + fr, col0 = u.pn * 256 + wc * 32 + 4 * fq;
#pragma unroll
        for (int ai = 0; ai < 2; ++ai)
#pragma unroll
            for (int m = 0; m < 4; ++m) { const size_t off = (size_t)(row0 + ai * 128 + m * 16) * D + col0;
#pragma unroll
                for (int bj = 0; bj < 2; ++bj)
#pragma unroll
                    for (int n = 0; n < 2; ++n) { const size_t o = off + bj * 128 + n * 16; *(f32x4*)(out + o) = *(const f32x4*)(x + o) + acc[ai][bj][m][n]; }
                if (m & 1) asm volatile("" ::: "memory"); }
    }
};
struct GroupSched {
    const LAS int* tab; int G, c;
    __device__ bool next(int i, Unit& u) const {
        const int L = i * G + c; if (L >= tab[32]) return false;
        int e = 0;
#pragma unroll 1
        for (int j = 1; j < 32; ++j) if (L >= tab[j]) e = j;
        const int rem = L - tab[e]; u.e = e; u.pm = rem >> 2; u.pn = rem & 3; const int n = tab[80 + e] - u.pm * 256; u.rows = n < 256 ? n : 256; u.base = tab[40 + e] + u.pm * 256; return true;
    }
};
struct ProbGateUp {
    static constexpr bool PERM = true;
    const bf16* A; const bf16* Bt; int K; const PInfo* pinfo; bf16* Hid; GroupSched S;
    __device__ bool next(int i, Unit& u) const { return S.next(i, u); }
    __device__ const char* b_base(const Unit& u) const { return (const char*)Bt + ((size_t)u.e * 1024 + (size_t)u.pn * 256) * K * 2; }
    __device__ void a_rows(const Unit& u, unsigned (&vA)[2][2], const int (&R)[2], const int (&C)[2]) const {
        const PInfo* pi = pinfo + (size_t)u.e * CAP + u.pm * 256;
#pragma unroll
        for (int h = 0; h < 2; ++h)
#pragma unroll
            for (int i = 0; i < 2; ++i) { const int r = h * 128 + R[i]; const int tok = r < u.rows ? (pi[r].dest >> 1) : 0; vA[h][i] = (unsigned)(tok * K + C[i]) * 2u; }
    }
    __device__ __forceinline__ void epi(const f32x4 (&acc)[2][2][4][2], const Unit& u, int wr, int wc, int fr, int fq) const {
        const PInfo* pi = pinfo + (size_t)u.e * CAP + u.pm * 256;
        const int col0 = u.pn * 128 + wc * 32 + 8 * fq;
#pragma unroll
        for (int ai = 0; ai < 2; ++ai)
#pragma unroll
            for (int m = 0; m < 4; ++m) { const int r = ai * 128 + wr * 64 + m * 16 + fr;
                if (r < u.rows) { const f32x4 inf = *(const f32x4*)(pi + r); const float w = inf.y, rs = inf.z;
                    float h[8];
#pragma unroll
                    for (int n = 0; n < 2; ++n)
#pragma unroll
                        for (int i = 0; i < 4; ++i) { const float a = rs * acc[ai][0][m][n][i], b = rs * acc[ai][1][m][n][i]; h[n * 4 + i] = a * sigmoidf_(a) * b * w; }
                    u32x4 o; o.x = cvt_pk_bf16(h[0], h[1]); o.y = cvt_pk_bf16(h[2], h[3]); o.z = cvt_pk_bf16(h[4], h[5]); o.w = cvt_pk_bf16(h[6], h[7]);
                    *(u32x4*)(Hid + (size_t)(u.base + r) * FE + col0) = o; } }
    }
};
struct ProbDown {
    static constexpr bool PERM = true;
    const bf16* A; const bf16* Bt; int K; const PInfo* pinfo; bf16* Yp; GroupSched S;
    __device__ bool next(int i, Unit& u) const { return S.next(i, u); }
    __device__ const char* b_base(const Unit& u) const { return (const char*)Bt + ((size_t)u.e * 1024 + (size_t)u.pn * 256) * K * 2; }
    __device__ void a_rows(const Unit& u, unsigned (&vA)[2][2], const int (&R)[2], const int (&C)[2]) const { dense_rows(u, K, vA, R, C); }
    __device__ __forceinline__ void epi(const f32x4 (&acc)[2][2][4][2], const Unit& u, int wr, int wc, int fr, int fq) const {
        const PInfo* pi = pinfo + (size_t)u.e * CAP + u.pm * 256;
        const int col0 = u.pn * 256 + wc * 32 + 8 * fq;
#pragma unroll
        for (int ai = 0; ai < 2; ++ai)
#pragma unroll
            for (int m = 0; m < 4; ++m) { const int r = ai * 128 + wr * 64 + m * 16 + fr;
                if (r < u.rows) { const int dest = pi[r].dest; bf16* rowp = Yp + (size_t)dest * D + col0;
#pragma unroll
                    for (int bj = 0; bj < 2; ++bj) { const f32x4 v0 = acc[ai][bj][m][0], v1 = acc[ai][bj][m][1];
                        u32x4 o; o.x = cvt_pk_bf16(v0[0], v0[1]); o.y = cvt_pk_bf16(v0[2], v0[3]); o.z = cvt_pk_bf16(v1[0], v1[1]); o.w = cvt_pk_bf16(v1[2], v1[3]);
                        *(u32x4*)(rowp + bj * 128) = o; } } }
    }
};
struct ProbPP {
    static constexpr bool PERM = true;
    const bf16* A; const bf16* Bt; int K; bf16* O; pg8::StaticOrder S;
    __device__ bool next(int i, Unit& u) const { return S.next(i, u); }
    __device__ const char* b_base(const Unit& u) const { return (const char*)Bt + (size_t)u.pn * 256 * K * 2; }
    __device__ void a_rows(const Unit& u, unsigned (&vA)[2][2], const int (&R)[2], const int (&C)[2]) const { dense_rows(u, K, vA, R, C); }
    __device__ __forceinline__ void epi(const f32x4 (&acc)[2][2][4][2], const Unit& u, int wr, int wc, int fr, int fq) const {
        const int row0 = u.pm * 256 + wr * 64 + fr, col0 = u.pn * 256 + wc * 32 + 8 * fq;
#pragma unroll
        for (int ai = 0; ai < 2; ++ai)
#pragma unroll
            for (int m = 0; m < 4; ++m) { bf16* rowp = O + (size_t)(row0 + ai * 128 + m * 16) * D + col0;
#pragma unroll
                for (int bj = 0; bj < 2; ++bj) { const f32x4 v0 = acc[ai][bj][m][0], v1 = acc[ai][bj][m][1];
                    u32x4 o; o.x = cvt_pk_bf16(v0[0], v0[1]); o.y = cvt_pk_bf16(v0[2], v0[3]); o.z = cvt_pk_bf16(v1[0], v1[1]); o.w = cvt_pk_bf16(v1[2], v1[3]);
                    *(u32x4*)(rowp + bj * 128) = o; } }
    }
};
struct ProbPleGate {
    static constexpr bool PERM = false;
    const bf16* A; const bf16* Bt; int K; const bf16* PP; const float* rstd; float* out; pg8::StaticOrder S;
    __device__ bool next(int i, Unit& u) const { return S.next(i, u); }
    __device__ const char* b_base(const Unit& u) const { return (const char*)Bt + (size_t)u.pn * 256 * K * 2; }
    __device__ void a_rows(const Unit& u, unsigned (&vA)[2][2], const int (&R)[2], const int (&C)[2]) const { dense_rows(u, K, vA, R, C); }
    __device__ __forceinline__ void epi(const f32x4 (&acc)[2][2][4][2], const Unit& u, int wr, int wc, int fr, int fq) const {
        const int row0 = u.pm * 256 + wr * 64 + fr, col0 = u.pn * 256 + wc * 32 + 4 * fq;
#pragma unroll
        for (int ai = 0; ai < 2; ++ai)
#pragma unroll
            for (int m = 0; m < 4; ++m) { const int row = row0 + ai * 128 + m * 16; const size_t off = (size_t)row * D + col0; const float rs = rstd[row];
#pragma unroll
                for (int bj = 0; bj < 2; ++bj)
#pragma unroll
                    for (int n = 0; n < 2; ++n) { const size_t o = off + bj * 128 + n * 16; const f32x4 x2 = *(const f32x4*)(out + o); const u32x2 pp = *(const u32x2*)(PP + o);
                        const f32x4 a = acc[ai][bj][m][n]; f32x4 r;
                        r[0] = x2[0] + sigmoidf_(rs * a[0]) * bf_lo(pp.x); r[1] = x2[1] + sigmoidf_(rs * a[1]) * bf_hi(pp.x);
                        r[2] = x2[2] + sigmoidf_(rs * a[2]) * bf_lo(pp.y); r[3] = x2[3] + sigmoidf_(rs * a[3]) * bf_hi(pp.y);
                        *(f32x4*)(out + o) = r; }
                if (m & 1) asm volatile("" ::: "memory"); }
    }
};

__device__ __forceinline__ void p2_mixer(Frame& F) {
    const bf16* Z = (const bf16*)(F.ws + WS_Z); bf16* Y = (bf16*)(F.ws + WS_Y);
    const float* wconv = F.in[4]; const float* gsgu = F.in[5]; const float* wsp = F.in[6]; const float* bsp = F.in[7];
    LAS unsigned char* lds = F.lds;
    LAS f32x2* stat = (LAS f32x2*)lds;
    LAS bf16* vT = (LAS bf16*)(lds + 1024);
    constexpr int VS = 136;
    const int tid = F.tid, lane = F.lane, wave = F.wave;
    for (int u = F.vcu; u < 256; u += F.G) {
        const int ci = u >> 1, hg = u & 1, t0 = ci * CH;
        {
            const int cg = tid & 31, rg = tid >> 5, col = hg * 256 + cg * 8, r0 = t0 + rg * 8;
            float w0[8], w1[8], w2[8];
#pragma unroll
            for (int j = 0; j < 2; ++j) { const f32x4 a = *(const f32x4*)(wconv + col + 4 * j), b = *(const f32x4*)(wconv + 512 + col + 4 * j), c = *(const f32x4*)(wconv + 1024 + col + 4 * j);
#pragma unroll
                for (int i = 0; i < 4; ++i) { w0[4 * j + i] = a[i]; w1[4 * j + i] = b[i]; w2[4 * j + i] = c[i]; } }
            u32x4 p2 = (u32x4){0u, 0u, 0u, 0u}, p1 = (u32x4){0u, 0u, 0u, 0u};
            const int sp = r0 & (SEQ - 1);
            if (sp >= 2) { p2 = *(const u32x4*)(Z + (size_t)(r0 - 2) * ZW + 512 + col); p1 = *(const u32x4*)(Z + (size_t)(r0 - 1) * ZW + 512 + col); }
#pragma unroll
            for (int i = 0; i < 8; ++i) { const size_t ro = (size_t)(r0 + i) * ZW;
                const u32x4 cz = *(const u32x4*)(Z + ro + 512 + col), bb = *(const u32x4*)(Z + ro + col);
                u32x4 o;
#pragma unroll
                for (int q = 0; q < 4; ++q) { const float ylo = bf_lo(bb[q]) * (w0[2 * q] * bf_lo(p2[q]) + w1[2 * q] * bf_lo(p1[q]) + w2[2 * q] * bf_lo(cz[q]));
                    const float yhi = bf_hi(bb[q]) * (w0[2 * q + 1] * bf_hi(p2[q]) + w1[2 * q + 1] * bf_hi(p1[q]) + w2[2 * q + 1] * bf_hi(cz[q])); o[q] = cvt_pk_bf16(ylo, yhi); }
                *(u32x4*)(Y + (size_t)(r0 + i) * D + col) = o; p2 = p1; p1 = cz; }
        }
        {
            const int row = tid >> 2, q = tid & 3; const bf16* vp = Z + (size_t)(t0 + row) * ZW + 1536 + q * 128;
            float s = 0.f, ss = 0.f;
#pragma unroll
            for (int j = 0; j < 16; ++j) { const u32x4 v = *(const u32x4*)(vp + 8 * j);
#pragma unroll
                for (int i = 0; i < 4; ++i) { const float a = bf_lo(v[i]), b = bf_hi(v[i]); s += a + b; ss += a * a + b * b; } }
            s += __shfl_xor(s, 1); s += __shfl_xor(s, 2); ss += __shfl_xor(ss, 1); ss += __shfl_xor(ss, 2);
            const float mean = s * (1.f / 512.f); const float var = fmaxf(ss * (1.f / 512.f) - mean * mean, 0.f);
            if (q == 0) stat[row] = (f32x2){mean, 1.0f / sqrtf(var + EPS)};
        }
        LDS_WAIT(); __syncthreads();
        {
            const int s = tid & 127, hl = tid >> 7; const f32x2 st = stat[s]; const int cbase = (4 * hg + hl) * 64;
            const bf16* vp = Z + (size_t)(t0 + s) * ZW + 1536 + cbase;
#pragma unroll
            for (int dg = 0; dg < 8; ++dg) { const u32x4 v = *(const u32x4*)(vp + 8 * dg); const f32x4 g0 = *(const f32x4*)(gsgu + cbase + 8 * dg), g1 = *(const f32x4*)(gsgu + cbase + 8 * dg + 4);
                float y[8];
                y[0] = (bf_lo(v.x) - st.x) * st.y * g0[0]; y[1] = (bf_hi(v.x) - st.x) * st.y * g0[1]; y[2] = (bf_lo(v.y) - st.x) * st.y * g0[2]; y[3] = (bf_hi(v.y) - st.x) * st.y * g0[3];
                y[4] = (bf_lo(v.z) - st.x) * st.y * g1[0]; y[5] = (bf_hi(v.z) - st.x) * st.y * g1[1]; y[6] = (bf_lo(v.w) - st.x) * st.y * g1[2]; y[7] = (bf_hi(v.w) - st.x) * st.y * g1[3];
#pragma unroll
                for (int j = 0; j < 8; j += 2) { const unsigned pk = cvt_pk_bf16(y[j], y[j + 1]);
                    vT[(hl * 64 + dg * 8 + j) * VS + s] = (bf16)(pk & 0xffffu); vT[(hl * 64 + dg * 8 + j + 1) * VS + s] = (bf16)(pk >> 16); } }
        }
        LDS_WAIT(); __syncthreads();
        {
            const int hl = wave >> 1, th = wave & 1, h = 4 * hg + hl, fr = lane & 15, fq = lane >> 4;
#pragma unroll 1
            for (int tt = 0; tt < 4; ++tt) {
                const int T0 = 64 * th + 16 * tt, tl = T0 + fr, ksteps = (T0 + 16 + 31) >> 5;
                f32x4 acc[4];
#pragma unroll
                for (int dt = 0; dt < 4; ++dt) acc[dt] = (f32x4){0.f, 0.f, 0.f, 0.f};
                const float* wrow = wsp + ((size_t)h * CH + tl) * CH;
#pragma unroll 1
                for (int ks = 0; ks < ksteps; ++ks) {
                    const int s0 = 32 * ks + 8 * fq; const f32x4 a = *(const f32x4*)(wrow + s0), b = *(const f32x4*)(wrow + s0 + 4);
                    float wv[8] = {a[0], a[1], a[2], a[3], b[0], b[1], b[2], b[3]};
#pragma unroll
                    for (int j = 0; j < 8; ++j) if (s0 + j > tl) wv[j] = 0.f;
                    u32x4 wp; wp.x = cvt_pk_bf16(wv[0], wv[1]); wp.y = cvt_pk_bf16(wv[2], wv[3]); wp.z = cvt_pk_bf16(wv[4], wv[5]); wp.w = cvt_pk_bf16(wv[6], wv[7]);
                    const bf16x8 bfrag = __builtin_bit_cast(bf16x8, wp);
#pragma unroll
                    for (int dt = 0; dt < 4; ++dt) { const bf16x8 afrag = *(const LAS bf16x8*)(vT + (hl * 64 + 16 * dt + fr) * VS + s0);
                        acc[dt] = __builtin_amdgcn_mfma_f32_16x16x32_bf16(afrag, bfrag, acc[dt], 0, 0, 0); }
                }
                const float bias = bsp[h * CH + tl]; const size_t trow = (size_t)(t0 + tl);
#pragma unroll
                for (int dt = 0; dt < 4; ++dt) { const int c = h * 64 + 16 * dt + 4 * fq; const u32x2 uu = *(const u32x2*)(Z + trow * ZW + 1024 + c);
                    const float y0 = bf_lo(uu.x) * (acc[dt][0] + bias), y1 = bf_hi(uu.x) * (acc[dt][1] + bias), y2 = bf_lo(uu.y) * (acc[dt][2] + bias), y3 = bf_hi(uu.y) * (acc[dt][3] + bias);
                    u32x2 o; o.x = cvt_pk_bf16(y0, y1); o.y = cvt_pk_bf16(y2, y3); *(u32x2*)(Y + trow * D + 512 + c) = o; }
            }
        }
        __syncthreads();
    }
}

__device__ __forceinline__ void p4_route(Frame& F) {
    const float* X1 = F.out; bf16* XB = (bf16*)(F.ws + WS_XN);
    const bf16* WRH = (const bf16*)(F.ws + WS_WR); const bf16* WRL = WRH + 48 * 1024;
    PInfo* pinfo = (PInfo*)(F.ws + WS_PINFO);
    unsigned* gcnt = F.ctl + CW_CNT;
    const float* bgrp = F.in[11]; const float* brt = F.in[13];
    LAS unsigned char* lds = F.lds;
    LAS float* part = (LAS float*)lds;
    LAS float* ssq = (LAS float*)(lds + 8 * 64 * 49 * 4);
    LAS int* lcnt = (LAS int*)(lds + 8 * 64 * 49 * 4 + 2048);
    LAS int* lbase = lcnt + 32;
    const int tid = F.tid, lane = F.lane, w = F.wave, fr = lane & 15, fq = lane >> 4;
    for (int unit = F.vcu; unit < T / 64; unit += F.G) {
        const int r0 = unit * 64;
        if (tid < 32) lcnt[tid] = 0;
        f32x4 acc[4][3]; float sq[4];
#pragma unroll
        for (int rt = 0; rt < 4; ++rt) { sq[rt] = 0.f;
#pragma unroll
            for (int ct = 0; ct < 3; ++ct) acc[rt][ct] = (f32x4){0.f, 0.f, 0.f, 0.f}; }
#pragma unroll 1
        for (int ks = 0; ks < 4; ++ks) {
            const int k = 128 * w + 32 * ks + 8 * fq;
            bf16x8 bh[3], bl[3];
#pragma unroll
            for (int ct = 0; ct < 3; ++ct) { bh[ct] = *(const bf16x8*)(WRH + (size_t)(16 * ct + fr) * D + k); bl[ct] = *(const bf16x8*)(WRL + (size_t)(16 * ct + fr) * D + k); }
#pragma unroll
            for (int rt = 0; rt < 4; ++rt) {
                const size_t off = (size_t)(r0 + 16 * rt + fr) * D + k;
                const f32x4 x0 = *(const f32x4*)(X1 + off), x1 = *(const f32x4*)(X1 + off + 4);
                sq[rt] += (x0[0] * x0[0] + x0[1] * x0[1]) + (x0[2] * x0[2] + x0[3] * x0[3]) + (x1[0] * x1[0] + x1[1] * x1[1]) + (x1[2] * x1[2] + x1[3] * x1[3]);
                u32x4 hi; hi.x = cvt_pk_bf16(x0[0], x0[1]); hi.y = cvt_pk_bf16(x0[2], x0[3]); hi.z = cvt_pk_bf16(x1[0], x1[1]); hi.w = cvt_pk_bf16(x1[2], x1[3]);
                u32x4 lo; lo.x = cvt_pk_bf16(x0[0] - bf_lo(hi.x), x0[1] - bf_hi(hi.x)); lo.y = cvt_pk_bf16(x0[2] - bf_lo(hi.y), x0[3] - bf_hi(hi.y));
                lo.z = cvt_pk_bf16(x1[0] - bf_lo(hi.z), x1[1] - bf_hi(hi.z)); lo.w = cvt_pk_bf16(x1[2] - bf_lo(hi.w), x1[3] - bf_hi(hi.w));
                *(u32x4*)(XB + off) = hi;
                const bf16x8 ah = __builtin_bit_cast(bf16x8, hi), al = __builtin_bit_cast(bf16x8, lo);
#pragma unroll
                for (int ct = 0; ct < 3; ++ct) {
                    acc[rt][ct] = __builtin_amdgcn_mfma_f32_16x16x32_bf16(ah, bh[ct], acc[rt][ct], 0, 0, 0);
                    acc[rt][ct] = __builtin_amdgcn_mfma_f32_16x16x32_bf16(al, bh[ct], acc[rt][ct], 0, 0, 0);
                    acc[rt][ct] = __builtin_amdgcn_mfma_f32_16x16x32_bf16(ah, bl[ct], acc[rt][ct], 0, 0, 0); }
            }
        }
#pragma unroll
        for (int rt = 0; rt < 4; ++rt) {
#pragma unroll
            for (int ct = 0; ct < 3; ++ct)
#pragma unroll
                for (int i = 0; i < 4; ++i) part[(w * 64 + 16 * rt + 4 * fq + i) * 49 + 16 * ct + fr] = acc[rt][ct][i];
            float s = sq[rt]; s += __shfl_xor(s, 16); s += __shfl_xor(s, 32);
            if (fq == 0) ssq[w * 64 + 16 * rt + fr] = s; }
        LDS_WAIT(); __syncthreads();
        int e1 = 0, e2 = 0, lp1 = 0, lp2 = 0; float w1 = 0.f, w2 = 0.f, rstd = 0.f;
        if (tid < 64) {
            const int row = tid;
            float ss = 0.f;
#pragma unroll
            for (int ww = 0; ww < 8; ++ww) ss += ssq[ww * 64 + row];
            rstd = 1.0f / sqrtf(ss * (1.f / D) + EPS);
            float gl[4];
#pragma unroll
            for (int o = 0; o < 4; ++o) { float s = 0.f;
#pragma unroll
                for (int ww = 0; ww < 8; ++ww) s += part[(ww * 64 + row) * 49 + o];
                gl[o] = rstd * s + bgrp[o]; }
            int gi = 0; float gm = gl[0];
#pragma unroll
            for (int o = 1; o < 4; ++o) if (gl[o] > gm) { gm = gl[o]; gi = o; }
            float gsum = 0.f;
#pragma unroll
            for (int o = 0; o < 4; ++o) gsum += __expf(gl[o] - gm);
            const float gw = 1.0f / gsum;
            float v1 = -INFINITY, v2 = -INFINITY; int i1 = 0, i2 = 0;
#pragma unroll
            for (int e = 0; e < 8; ++e) { float s = 0.f;
#pragma unroll
                for (int ww = 0; ww < 8; ++ww) s += part[(ww * 64 + row) * 49 + 4 + gi * 8 + e];
                const float v = rstd * s + brt[gi * 8 + e];
                if (v > v1) { v2 = v1; i2 = i1; v1 = v; i1 = e; } else if (v > v2) { v2 = v; i2 = e; } }
            const float ex = __expf(v2 - v1); const float p1 = 1.0f / (1.0f + ex);
            w1 = gw * p1; w2 = gw * (ex * p1);
            e1 = gi * 8 + i1; e2 = gi * 8 + i2;
            lp1 = atomicAdd((int*)&lcnt[e1], 1); lp2 = atomicAdd((int*)&lcnt[e2], 1);
        }
        LDS_WAIT(); __syncthreads();
        if (tid < 32) { const int c = lcnt[tid]; lbase[tid] = c > 0 ? (int)__hip_atomic_fetch_add(gcnt + tid, (unsigned)c, __ATOMIC_RELAXED, __HIP_MEMORY_SCOPE_AGENT) : 0; }
        LDS_WAIT(); __syncthreads();
        if (tid < 64) {
            const int t = r0 + tid;
            PInfo a; a.dest = 2 * t; a.w = w1; a.rstd = rstd; a.pad = 0; PInfo b; b.dest = 2 * t + 1; b.w = w2; b.rstd = rstd; b.pad = 0;
            *(u32x4*)(pinfo + (size_t)e1 * CAP + lbase[e1] + lp1) = __builtin_bit_cast(u32x4, a);
            *(u32x4*)(pinfo + (size_t)e2 * CAP + lbase[e2] + lp2) = __builtin_bit_cast(u32x4, b);
        }
        __syncthreads();
    }
}

__device__ __forceinline__ void build_tables(Frame& F) {
    LAS int* tab = (LAS int*)(F.lds + TAB_OFF);
    if (F.tid == 0) {
        int ts = 0, ho = 0;
        for (int e = 0; e < NE; ++e) { const int c = (int)__hip_atomic_load(F.ctl + CW_CNT + e, __ATOMIC_RELAXED, __HIP_MEMORY_SCOPE_AGENT); tab[e] = ts; tab[40 + e] = ho; tab[80 + e] = c; ts += ((c + 255) >> 8) * 4; ho += c; }
        tab[32] = ts; tab[72] = ho;
    }
    LDS_WAIT(); __syncthreads();
}

__device__ __forceinline__ void p7_combine(Frame& F) {
    float* X = F.out; const bf16* Yp = (const bf16*)(F.ws + WS_Z); bf16* XB = (bf16*)(F.ws + WS_XN); float* rstd2 = (float*)(F.ws + WS_RSTD);
    const int gw = F.vcu * NWAVES + F.wave, NGW = F.G * NWAVES;
    for (int m = gw; m < T; m += NGW) {
        f32x4* xr = (f32x4*)(X + (size_t)m * D) + F.lane; const u32x2* y0 = (const u32x2*)(Yp + (size_t)(2 * m) * D) + F.lane; const u32x2* y1 = (const u32x2*)(Yp + (size_t)(2 * m + 1) * D) + F.lane;
        u32x2* ob = (u32x2*)(XB + (size_t)m * D) + F.lane;
        f32x4 v[4]; float s = 0.f;
#pragma unroll
        for (int j = 0; j < 4; ++j) { v[j] = xr[64 * j]; const u32x2 a = y0[64 * j], b = y1[64 * j];
            v[j].x += bf_lo(a.x) + bf_lo(b.x); v[j].y += bf_hi(a.x) + bf_hi(b.x); v[j].z += bf_lo(a.y) + bf_lo(b.y); v[j].w += bf_hi(a.y) + bf_hi(b.y);
            s += (v[j].x * v[j].x + v[j].y * v[j].y) + (v[j].z * v[j].z + v[j].w * v[j].w); }
        s = wave_sum(s);
#pragma unroll
        for (int j = 0; j < 4; ++j) { xr[64 * j] = v[j]; u32x2 w; w.x = cvt_pk_bf16(v[j].x, v[j].y); w.y = cvt_pk_bf16(v[j].z, v[j].w); ob[64 * j] = w; }
        if (F.lane == 0) rstd2[m] = 1.0f / sqrtf(s * (1.f / D) + EPS);
    }
}
__device__ __forceinline__ void p10_final(Frame& F) {
    float* X = F.out; const float* g = F.in[20];
    const int gw = F.vcu * NWAVES + F.wave, NGW = F.G * NWAVES;
    f32x4 gv[4];
#pragma unroll
    for (int j = 0; j < 4; ++j) gv[j] = *((const f32x4*)g + F.lane + 64 * j);
    for (int m = gw; m < T; m += NGW) {
        f32x4* xr = (f32x4*)(X + (size_t)m * D) + F.lane;
        f32x4 v[4]; float s = 0.f;
#pragma unroll
        for (int j = 0; j < 4; ++j) { v[j] = xr[64 * j]; s += (v[j].x * v[j].x + v[j].y * v[j].y) + (v[j].z * v[j].z + v[j].w * v[j].w); }
        const float rstd = 1.0f / sqrtf(wave_sum(s) * (1.f / D) + EPS);
#pragma unroll
        for (int j = 0; j < 4; ++j) xr[64 * j] = v[j] * rstd * gv[j];
    }
}

struct Args { const float* in[21]; float* out; unsigned char* ws; int ph_lo, ph_hi, li, pad; };
constexpr int N_PHASES = 11;

__global__ void __launch_bounds__(NTHR, 2) fwd_kernel(Args args) {
    extern __shared__ __attribute__((aligned(16))) unsigned char lds_raw[];
    Frame F;
    F.lds = (LAS unsigned char*)lds_raw;
    F.tid = threadIdx.x; F.lane = F.tid & 63; F.wave = __builtin_amdgcn_readfirstlane(F.tid >> 6);
    F.G = gridDim.x; { const int bx = blockIdx.x; F.vcu = (F.G % 8 == 0) ? (bx % 8) * (F.G / 8) + bx / 8 : bx; }
#pragma unroll
    for (int i = 0; i < 21; ++i) F.in[i] = args.in[i];
    F.out = args.out; F.ws = args.ws; F.ctl = (unsigned*)(args.ws + WS_CTL);
    volatile LAS unsigned* MISC = (volatile LAS unsigned*)(F.lds + LDSCTL_OFF);
    for (int u = F.tid; u < 64; u += NTHR) MISC[u] = 0u;
    __syncthreads();
    const int lo = args.ph_lo, hi = args.ph_hi;
    XcdBarrier bar; bar.bar = F.ctl + CW_BAR; bar.x = 0; bar.st = nullptr;
    if (hi - lo > 1) bar = xcd_barrier_post(F.ctl + CW_BAR, MISC + 8);
#define IN(k) (lo <= (k) && (k) < hi)
#define SEAM(k) do { if (IN(k) && IN((k) + 1)) xcd_barrier(bar); } while (0)
    unsigned char* ws = F.ws;
    const int bx = (int)blockIdx.x;

    if (IN(0)) { p0_prologue(F); } SEAM(0);
    if (IN(1)) {
        ProbInProj P; P.A = (const bf16*)(ws + WS_XN); P.Bt = (const bf16*)(ws + WS_WIN); P.K = D; P.Z = (bf16*)(ws + WS_Z); P.S.init(T, NIN, F.G, bx);
        pg8::gemm_phase<ProbInProj, true>(F.lds, P);
    } SEAM(1);
    if (IN(2)) { p2_mixer(F); } SEAM(2);
    if (IN(3)) {
        ProbOutProj P; P.A = (const bf16*)(ws + WS_Y); P.Bt = (const bf16*)(ws + WS_WOUT); P.K = D; P.x = F.in[0]; P.out = F.out; P.S.init(T, D, F.G, bx);
        pg8::gemm_phase<ProbOutProj, true>(F.lds, P);
    } SEAM(3);
    if (IN(4)) { p4_route(F); } SEAM(4);
    if (IN(5)) {
        build_tables(F);
        ProbGateUp P; P.A = (const bf16*)(ws + WS_XN); P.Bt = (const bf16*)(ws + WS_WGU); P.K = D; P.pinfo = (const PInfo*)(ws + WS_PINFO); P.Hid = (bf16*)(ws + WS_Y);
        P.S.tab = (const LAS int*)(F.lds + TAB_OFF); P.S.G = F.G; P.S.c = F.vcu;
        pg8::gemm_phase<ProbGateUp, true>(F.lds, P);
    } SEAM(5);
    if (IN(6)) {
        build_tables(F);
        ProbDown P; P.A = (const bf16*)(ws + WS_Y); P.Bt = (const bf16*)(ws + WS_WDN); P.K = FE; P.pinfo = (const PInfo*)(ws + WS_PINFO); P.Yp = (bf16*)(ws + WS_Z);
        P.S.tab = (const LAS int*)(F.lds + TAB_OFF); P.S.G = F.G; P.S.c = F.vcu;
        pg8::gemm_phase<ProbDown, true>(F.lds, P);
    } SEAM(6);
    if (IN(7)) { p7_combine(F); } SEAM(7);
    if (IN(8)) {
        ProbPP P; P.A = (const bf16*)(ws + WS_PBF); P.Bt = (const bf16*)(ws + WS_WPP); P.K = PLE; P.O = (bf16*)(ws + WS_Y); P.S.init(T, D, F.G, bx);
        pg8::gemm_phase<ProbPP, true>(F.lds, P);
    } SEAM(8);
    if (IN(9)) {
        ProbPleGate P; P.A = (const bf16*)(ws + WS_XN); P.Bt = (const bf16*)(ws + WS_WPG); P.K = D; P.PP = (const bf16*)(ws + WS_Y); P.rstd = (const float*)(ws + WS_RSTD); P.out = F.out; P.S.init(T, D, F.G, bx);
        pg8::gemm_phase<ProbPleGate, true>(F.lds, P);
    } SEAM(9);
    if (IN(10)) { p10_final(F); }
#undef IN
#undef SEAM
}

extern "C" void kernel_launch(void* const* d_in, const int* in_sizes, int n_in, void* d_out, int out_size, void* d_ws, size_t ws_size, hipStream_t stream) {
    static int grid = 0;
    if (grid == 0) {
        if (n_in != 21 || in_sizes[0] != T * D || out_size != T * D || ws_size < WS_END) { fprintf(stderr, "kernel_launch: unexpected shapes (n_in %d, in0 %d, out %d, ws %zu)\n", n_in, n_in > 0 ? in_sizes[0] : -1, out_size, ws_size); grid = -1; return; }
        int dev = 0, cus = 0, per_cu = 0;
        if (hipGetDevice(&dev) != hipSuccess || hipDeviceGetAttribute(&cus, hipDeviceAttributeMultiprocessorCount, dev) != hipSuccess) { grid = -1; return; }
        if (hipFuncSetAttribute((const void*)fwd_kernel, hipFuncAttributeMaxDynamicSharedMemorySize, LDS_BYTES) != hipSuccess) { fprintf(stderr, "kernel_launch: hipFuncSetAttribute failed\n"); grid = -1; return; }
        if (hipOccupancyMaxActiveBlocksPerMultiprocessor(&per_cu, (const void*)fwd_kernel, NTHR, LDS_BYTES) != hipSuccess || per_cu < 1) fprintf(stderr, "kernel_launch: occupancy query reports %d blocks per CU\n", per_cu);
        (void)hipGetLastError();
        grid = cus;
    }
    if (grid < 0) return;
    (void)hipMemsetAsync((char*)d_ws + WS_CTL, 0, CTL_ZERO_BYTES, stream);
    Args a{};
    for (int i = 0; i < 21; ++i) a.in[i] = (const float*)d_in[i];
    a.out = (float*)d_out; a.ws = (unsigned char*)d_ws;
#if MK_ONE_LAUNCH
    a.ph_lo = 0; a.ph_hi = N_PHASES; a.li = 0;
    hipLaunchKernelGGL(fwd_kernel, dim3(grid), dim3(NTHR), LDS_BYTES, stream, a);
#else
    for (int li = 0; li < N_PHASES; ++li) { a.ph_lo = li; a.ph_hi = li + 1; a.li = li; hipLaunchKernelGGL(fwd_kernel, dim3(grid), dim3(NTHR), LDS_BYTES, stream, a); }
#endif
}
```

```cpp
#include <hip/hip_runtime.h>
#include <cstdio>
#include <cstdint>

#ifndef DUP_PHASE
#define DUP_PHASE -1
#endif
#ifndef MK_ONE_LAUNCH
#define MK_ONE_LAUNCH 1
#endif

#define GAS __attribute__((address_space(1)))
#define LAS __attribute__((address_space(3)))
typedef unsigned short bf16;
typedef short bf16x8 __attribute__((ext_vector_type(8)));
typedef float f32x4 __attribute__((ext_vector_type(4)));
typedef float f32x2 __attribute__((ext_vector_type(2)));
typedef unsigned u32x4 __attribute__((ext_vector_type(4)));
typedef unsigned u32x2 __attribute__((ext_vector_type(2)));

constexpr int T = 16384, D = 1024, SEQ = 4096, NIN = 2560, ZW = 2048, CH = 128, NE = 32, FE = 512, PLE = 256, CAP = 16384;
constexpr float EPS = 1e-6f;
constexpr int NWAVES = 8, NTHR = 512;

constexpr size_t MiB = 1u << 20;
constexpr size_t WS_CTL = 0, CTL_ZERO_BYTES = 64 * 1024;
constexpr size_t WS_WIN = 1 * MiB;
constexpr size_t WS_WOUT = 6 * MiB;
constexpr size_t WS_WPG = 8 * MiB;
constexpr size_t WS_WPP = 10 * MiB;
constexpr size_t WS_WR = 10 * MiB + 512 * 1024;
constexpr size_t WS_RSTD = 10 * MiB + 768 * 1024;
constexpr size_t WS_PINFO = 11 * MiB;
constexpr size_t WS_PBF = 19 * MiB;
constexpr size_t WS_WGU = 28 * MiB;
constexpr size_t WS_WDN = 92 * MiB;
constexpr size_t WS_XN = 124 * MiB;
constexpr size_t WS_Z = 156 * MiB;
constexpr size_t WS_Y = 220 * MiB;
constexpr size_t WS_END = 253 * MiB;
constexpr int CW_CNT = 64;
constexpr int CW_BAR = 4096;

constexpr int RING_BYTES = 131072;
constexpr int LDSCTL_OFF = RING_BYTES;
constexpr int TAB_OFF = RING_BYTES + 1024;
constexpr int LDS_BYTES = 147456;

#define LDS_WAIT() asm volatile("s_waitcnt lgkmcnt(0)" ::: "memory")
#define VM_WAIT() asm volatile("s_waitcnt vmcnt(0)" ::: "memory")

__device__ __forceinline__ unsigned cvt_pk_bf16(float lo, float hi) { unsigned r; asm volatile("v_cvt_pk_bf16_f32 %0, %1, %2" : "=v"(r) : "v"(lo), "v"(hi)); return r; }
__device__ __forceinline__ float bf_lo(unsigned u) { return __builtin_bit_cast(float, u << 16); }
__device__ __forceinline__ float bf_hi(unsigned u) { return __builtin_bit_cast(float, u & 0xffff0000u); }
__device__ __forceinline__ float fast_rcp(float x) { return __builtin_amdgcn_rcpf(x); }
__device__ __forceinline__ float fast_exp(float x) { return __builtin_amdgcn_exp2f(x * 1.4426950408889634f); }
__device__ __forceinline__ float sigmoidf_(float x) { return fast_rcp(1.0f + fast_exp(-x)); }
__device__ __forceinline__ float gelu_tanh(float v) { const float y = 1.5957691216057308f * (v + 0.044715f * v * v * v); return v * fast_rcp(1.0f + fast_exp(-y)); }
__device__ __forceinline__ float wave_sum(float v) {
#pragma unroll
    for (int o = 1; o < 64; o <<= 1) v += __shfl_xor(v, o);
    return v;
}

namespace pg8 {
constexpr int BM = 256, BK = 64, HALF = 128, HTB = HALF * BK * 2, STAGE_BYTES = 8 * HTB, NXCD = 8, WGM = 8;
__host__ __device__ __forceinline__ int lds_byte(int r, int c) { const int st = (r >> 4) * 2 + (c >> 5), rr = r & 15, cc = c & 31, ob = rr * 64 + cc * 2; return st * 1024 + (ob ^ (((ob >> 9) & 1) << 5)); }
__host__ __device__ __forceinline__ void stage_rc(int b, int& R, int& C) { const int st = b / 1024, sb = b % 1024, swz = sb ^ (((sb >> 9) & 1) << 5); R = (st >> 1) * 16 + swz / 64; C = (st & 1) * 32 + (swz % 64) / 2; }
__host__ __device__ __forceinline__ int perm32(int rho) { const int n = rho >> 4, i = rho & 15; return 8 * (i >> 2) + 4 * n + (i & 3); }

struct Unit { int pm, pn, e, rows, base; };

struct StaticOrder {
    int nM, nN, nwg, G, c;
    __device__ void init(int M, int N, int G_, int c_) { nM = M / BM; nN = N / BM; nwg = nM * nN; G = G_; c = c_; }
    __device__ bool next(int i, Unit& u) const {
        const long L = (long)i * G + c; if (L >= nwg) return false;
        int wgid = (int)L; { const int q = nwg / NXCD, r = nwg % NXCD, xcd = wgid % NXCD, off = wgid / NXCD; wgid = (xcd < r ? xcd * (q + 1) : r * (q + 1) + (xcd - r) * q) + off; }
        const int nig = WGM * nN, gid = wgid / nig, fm = gid * WGM, gsz = (nM - fm) < WGM ? (nM - fm) : WGM;
        u.pm = fm + ((wgid % nig) % gsz); u.pn = (wgid % nig) / gsz; u.e = 0; u.rows = BM; u.base = u.pm * BM; return true;
    }
};

template <class P, bool ALIGN_EPI>
__device__ __forceinline__ void gemm_phase(LAS unsigned char* lds, const P& p) {
    const int tid = threadIdx.x, wid = __builtin_amdgcn_readfirstlane(tid >> 6), lane = tid & 63, wr = wid >> 2, wc = wid & 3, fr = lane & 15, fq = lane >> 4;
    const int K = p.K, nt = K / BK;
    int Rr[2], Cc[2]; unsigned voffB[2];
#pragma unroll
    for (int i = 0; i < 2; ++i) { stage_rc(tid * 16 + i * 8192, Rr[i], Cc[i]); const int Rb = P::PERM ? ((Rr[i] & ~31) + perm32(Rr[i] & 31)) : Rr[i]; voffB[i] = (unsigned)(Rb * K + Cc[i]) * 2u; }
    const size_t kstep = (size_t)(BK * 2), hstep = (size_t)HALF * K * 2;
    const unsigned ldsw = (unsigned)wid * 1024u;
    const int aoff = lds_byte(wr * 64 + fr, fq * 8), boff = lds_byte(wc * 32 + fr, fq * 8);
#define PG8_SA(b, h) (((b) * 2 + (h)) * HTB)
#define PG8_SB(b, h) ((4 + (b) * 2 + (h)) * HTB)
#define PG8_STAGE(bufoff, gbase, voff) do { _Pragma("unroll") for (int _i = 0; _i < 2; ++_i) \
        __builtin_amdgcn_global_load_lds((const unsigned*)((const char*)(gbase) + (voff)[_i]), (LAS unsigned*)(lds + (bufoff) + ldsw + _i * 8192), 16, 0, 0); } while (0)
#define PG8_LDA(dst, b, h) do { _Pragma("unroll") for (int m = 0; m < 4; ++m) _Pragma("unroll") for (int k = 0; k < 2; ++k) dst[m][k] = *(const LAS bf16x8*)(lds + PG8_SA(b, h) + aoff + m * 2048 + k * 1024); } while (0)
#define PG8_LDB(dst, b, h) do { _Pragma("unroll") for (int n = 0; n < 2; ++n) _Pragma("unroll") for (int k = 0; k < 2; ++k) dst[n][k] = *(const LAS bf16x8*)(lds + PG8_SB(b, h) + boff + n * 2048 + k * 1024); } while (0)
#define PG8_MMA(ai, bj, At, Bt) do { __builtin_amdgcn_s_setprio(1); _Pragma("unroll") for (int m = 0; m < 4; ++m) _Pragma("unroll") for (int n = 0; n < 2; ++n) _Pragma("unroll") for (int k = 0; k < 2; ++k) \
        acc[ai][bj][m][n] = __builtin_amdgcn_mfma_f32_16x16x32_bf16(Bt[n][k], At[m][k], acc[ai][bj][m][n], 0, 0, 0); __builtin_amdgcn_s_setprio(0); } while (0)
#define PG8_WAIT_V(n) asm volatile("s_waitcnt vmcnt(" #n ")" ::: "memory")
#define PG8_WAIT_L(n) asm volatile("s_waitcnt lgkmcnt(" #n ")" ::: "memory")
#define PG8_BAR __builtin_amdgcn_s_barrier()
#define PG8_SCHED __builtin_amdgcn_sched_barrier(0)
    Unit cur, nxt; int ui = 0;
    if (!p.next(0, cur)) return;
    f32x4 acc[2][2][4][2];
#pragma unroll
    for (int a = 0; a < 2; ++a)
#pragma unroll
        for (int b = 0; b < 2; ++b)
#pragma unroll
            for (int m = 0; m < 4; ++m)
#pragma unroll
                for (int n = 0; n < 2; ++n) acc[a][b][m][n] = (f32x4){0.f, 0.f, 0.f, 0.f};
    bf16x8 At[4][2], B0[2][2], B1[2][2];
    unsigned vAc[2][2], vAn[2][2];
    p.a_rows(cur, vAc, Rr, Cc);
    const char* gA = (const char*)p.A;
    const char* cB = p.b_base(cur);
    PG8_STAGE(PG8_SB(0, 0), cB, voffB); PG8_STAGE(PG8_SB(0, 1), cB + hstep, voffB); PG8_STAGE(PG8_SA(0, 0), gA, vAc[0]); PG8_STAGE(PG8_SA(0, 1), gA, vAc[1]);
    if (wr == 1) PG8_BAR;
    PG8_WAIT_V(2); PG8_BAR;
    PG8_STAGE(PG8_SB(1, 0), cB + kstep, voffB); PG8_STAGE(PG8_SA(1, 0), gA + kstep, vAc[0]); PG8_STAGE(PG8_SB(1, 1), cB + hstep + kstep, voffB);
    PG8_WAIT_V(6); PG8_BAR;
    for (;;) {
        const bool has_next = p.next(ui + 1, nxt);
        const char* nB = has_next ? p.b_base(nxt) : cB;
        if (has_next) p.a_rows(nxt, vAn, Rr, Cc);
        else { vAn[0][0] = vAc[0][0]; vAn[0][1] = vAc[0][1]; vAn[1][0] = vAc[1][0]; vAn[1][1] = vAc[1][1]; }
        for (int t = 0; t < nt; t += 2) {
            const bool last = (t == nt - 2);
            const char* a1 = gA + (size_t)(t + 1) * kstep;
            const char* a2 = last ? gA : gA + (size_t)(t + 2) * kstep; const char* b2 = last ? nB : cB + (size_t)(t + 2) * kstep;
            const char* a3 = a2 + kstep; const char* b3 = b2 + kstep;
            unsigned s0[2], s1[2];
            s0[0] = last ? vAn[0][0] : vAc[0][0]; s0[1] = last ? vAn[0][1] : vAc[0][1]; s1[0] = last ? vAn[1][0] : vAc[1][0]; s1[1] = last ? vAn[1][1] : vAc[1][1];
            PG8_LDB(B0, 0, 0); PG8_LDB(B1, 0, 1); PG8_SCHED; PG8_LDA(At, 0, 0); PG8_STAGE(PG8_SA(1, 1), a1, vAc[1]);
            PG8_WAIT_V(8); PG8_WAIT_L(0); PG8_BAR; PG8_MMA(0, 0, At, B0); PG8_MMA(0, 1, At, B1); PG8_BAR; PG8_SCHED;
            PG8_LDA(At, 0, 1); PG8_STAGE(PG8_SB(0, 0), b2, voffB); PG8_STAGE(PG8_SB(0, 1), b2 + hstep, voffB); PG8_STAGE(PG8_SA(0, 0), a2, s0);
            PG8_WAIT_V(8); PG8_WAIT_L(0); PG8_BAR; PG8_MMA(1, 0, At, B0); PG8_MMA(1, 1, At, B1); PG8_BAR; PG8_SCHED;
            PG8_LDB(B0, 1, 0); PG8_LDB(B1, 1, 1); PG8_SCHED; PG8_LDA(At, 1, 0); PG8_STAGE(PG8_SA(0, 1), a2, s1);
            PG8_WAIT_V(8); PG8_WAIT_L(0); PG8_BAR; PG8_MMA(0, 0, At, B0); PG8_MMA(0, 1, At, B1); PG8_BAR; PG8_SCHED;
            PG8_LDA(At, 1, 1); PG8_STAGE(PG8_SB(1, 0), b3, voffB); PG8_STAGE(PG8_SB(1, 1), b3 + hstep, voffB); PG8_STAGE(PG8_SA(1, 0), a3, s0);
            PG8_WAIT_V(8); PG8_WAIT_L(0); PG8_BAR; PG8_MMA(1, 0, At, B0); PG8_MMA(1, 1, At, B1); PG8_BAR; PG8_SCHED;
        }
        if constexpr (ALIGN_EPI) { if (wr == 0) PG8_BAR; }
        p.epi(acc, cur, wr, wc, fr, fq);
        if (!has_next) break;
#pragma unroll
        for (int a = 0; a < 2; ++a)
#pragma unroll
            for (int b = 0; b < 2; ++b)
#pragma unroll
                for (int m = 0; m < 4; ++m)
#pragma unroll
                    for (int n = 0; n < 2; ++n) acc[a][b][m][n] = (f32x4){0.f, 0.f, 0.f, 0.f};
        cur = nxt; cB = nB; ++ui;
        vAc[0][0] = vAn[0][0]; vAc[0][1] = vAn[0][1]; vAc[1][0] = vAn[1][0]; vAc[1][1] = vAn[1][1];
        if constexpr (ALIGN_EPI) { if (wr == 1) PG8_BAR; }
    }
    PG8_WAIT_V(0);
    if constexpr (!ALIGN_EPI) { if (wr == 0) PG8_BAR; }
    PG8_BAR;
#undef PG8_SA
#undef PG8_SB
#undef PG8_STAGE
#undef PG8_LDA
#undef PG8_LDB
#undef PG8_MMA
#undef PG8_WAIT_V
#undef PG8_WAIT_L
#undef PG8_BAR
#undef PG8_SCHED
}
}
using pg8::Unit;

#define XB_TMO      128
#define XB_XCNT(j)  (256  + 64 * (j))
#define XB_XSUB(j)  (1280 + 64 * (j))
#define XB_XGEN(j)  (2304 + 64 * (j))
#define XB_TOP      3328
#define XB_TOPGEN   3392
#define XCD_BAR_WORDS 3456
#define XB_SPIN_CAP (1u << 18)
__device__ __forceinline__ unsigned xb_ld(unsigned* p)              { return __hip_atomic_load(p, __ATOMIC_RELAXED, __HIP_MEMORY_SCOPE_AGENT); }
__device__ __forceinline__ unsigned xb_add(unsigned* p, unsigned v) { return __hip_atomic_fetch_add(p, v, __ATOMIC_RELAXED, __HIP_MEMORY_SCOPE_AGENT); }
__device__ __forceinline__ unsigned xb_xcc_id() { return (unsigned)__builtin_amdgcn_s_getreg((3 << 11) | 20) & 0xFu; }
#define XB_SPIN(cond, bar) do { unsigned _sp = 0; while (cond) { __builtin_amdgcn_s_sleep(1); \
    if ((++_sp & 255u) == 0u) { if (xb_ld(&(bar)[XB_TMO])) break; if (_sp > XB_SPIN_CAP) { atomicAdd(&(bar)[XB_TMO], 1u); break; } } } } while (0)
struct XcdBarrier { unsigned* bar; unsigned x; volatile LAS unsigned* st; };
__device__ __forceinline__ XcdBarrier xcd_barrier_post(unsigned* bar, volatile LAS unsigned* st) {
    XcdBarrier b; b.bar = bar; b.x = xb_xcc_id(); b.st = st;
    if (threadIdx.x == 0) (void)xb_add(&bar[XB_XCNT(b.x)], 1u);
    return b;
}
__device__ __forceinline__ void xcd_barrier_complete(unsigned* bar, unsigned x, unsigned& nloc, unsigned& nx) {
    const unsigned G = gridDim.x * gridDim.y * gridDim.z;
    unsigned sum, cnt, mine, sp = 0u;
    for (;;) {
        sum = 0u; cnt = 0u; mine = 0u;
#pragma unroll
        for (unsigned j = 0; j < 16; ++j) { const unsigned c = xb_ld(&bar[XB_XCNT(j)]); sum += c; cnt += (c > 0u) ? 1u : 0u; mine = (j == x) ? c : mine; }
        if (sum == G) break;
        __builtin_amdgcn_s_sleep(1);
        if ((++sp & 255u) == 0u) { if (xb_ld(&bar[XB_TMO])) break; if (sp > XB_SPIN_CAP) { atomicAdd(&bar[XB_TMO], 1u); break; } }
    }
    nloc = mine > 0u ? mine : 1u; nx = cnt > 0u ? cnt : 1u;
}
__device__ __forceinline__ void xcd_barrier(const XcdBarrier& b) {
    asm volatile("s_waitcnt vmcnt(0)" ::: "memory");
    __syncthreads();
    if (threadIdx.x == 0) {
        unsigned* bar = b.bar;
        __builtin_amdgcn_s_waitcnt(0);
        unsigned nloc = b.st[0], nx = b.st[1];
        if (nloc == 0u) { xcd_barrier_complete(bar, b.x, nloc, nx); b.st[0] = nloc; b.st[1] = nx; }
        const unsigned old = xb_add(&bar[XB_XSUB(b.x)], 1u);
        const unsigned gen = old / nloc;
        if (old + 1u == (gen + 1u) * nloc) {
            __builtin_amdgcn_fence(__ATOMIC_RELEASE, "agent");
            asm volatile("s_waitcnt vmcnt(0)" ::: "memory");
            const unsigned og = xb_add(&bar[XB_TOP], 1u);
            const unsigned tg = og / nx;
            if (og + 1u == (tg + 1u) * nx) xb_add(&bar[XB_TOPGEN], 1u);
            else XB_SPIN(xb_ld(&bar[XB_TOPGEN]) == tg, bar);
            __builtin_amdgcn_fence(__ATOMIC_ACQUIRE, "agent");
            xb_add(&bar[XB_XGEN(b.x)], 1u);
            asm volatile("s_waitcnt vmcnt(0)" ::: "memory");
        } else {
            XB_SPIN(xb_ld(&bar[XB_XGEN(b.x)]) == gen, bar);
            __builtin_amdgcn_fence(__ATOMIC_ACQUIRE, "agent");
            asm volatile("s_waitcnt vmcnt(0)" ::: "memory");
        }
    }
    __syncthreads();
}

struct Frame {
    LAS unsigned char* lds;
    unsigned* ctl;
    int tid, lane, wave, vcu, G;
    const float* in[21]; float* out; unsigned char* ws;
};
struct PInfo { int dest; float w; float rstd; int pad; };

__device__ __forceinline__ int map_row(int mode, int n) {
    if (mode == 1) { if (n < 512 || n >= 1536) return n; if (n < 1024) { const int j = n - 512; return 512 + (j >> 7) * 256 + (j & 127); } const int j = n - 1024; return 512 + (j >> 7) * 256 + 128 + (j & 127); }
    if (mode == 2) return (n >> 7) * 256 + (n & 127);
    if (mode == 3) return (n >> 7) * 256 + 128 + (n & 127);
    return n;
}
__device__ __forceinline__ void p0_transpose_item(const float* W, int K, int N, bf16* WT, int mode, const float* gs, LAS unsigned char* scr, int item, int lane) {
    const int nblk = N >> 6, kb = item / nblk, nb = item - kb * nblk, k0 = 64 * kb, n0 = 64 * nb;
    const int r = lane >> 4, c = lane & 15;
    const float* src = W + (size_t)(k0 + 16 * r) * N + n0 + 4 * c;
    f32x4 v[16];
#pragma unroll
    for (int j = 0; j < 16; ++j) v[j] = *(const f32x4*)(src + (size_t)j * N);
    if (gs) {
        f32x4 g[4];
#pragma unroll
        for (int j = 0; j < 4; ++j) g[j] = *(const f32x4*)(gs + k0 + 16 * r + 4 * j);
#pragma unroll
        for (int j = 0; j < 16; ++j) v[j] = v[j] * g[j >> 2][j & 3];
    }
#pragma unroll
    for (int q = 0; q < 4; ++q) {
        u32x4 a, b;
        a.x = cvt_pk_bf16(v[0][q], v[1][q]); a.y = cvt_pk_bf16(v[2][q], v[3][q]); a.z = cvt_pk_bf16(v[4][q], v[5][q]); a.w = cvt_pk_bf16(v[6][q], v[7][q]);
        b.x = cvt_pk_bf16(v[8][q], v[9][q]); b.y = cvt_pk_bf16(v[10][q], v[11][q]); b.z = cvt_pk_bf16(v[12][q], v[13][q]); b.w = cvt_pk_bf16(v[14][q], v[15][q]);
        LAS unsigned char* d = scr + (4 * c + q) * 144 + 32 * r;
        *(LAS u32x4*)d = a; *(LAS u32x4*)(d + 16) = b;
    }
    LDS_WAIT(); asm volatile("" ::: "memory");
    const int ch = lane & 7;
#pragma unroll
    for (int i = 0; i < 8; ++i) { const int n = (lane >> 3) + 8 * i; const u32x4 o = *(const LAS u32x4*)(scr + n * 144 + 16 * ch);
        *(u32x4*)(WT + (size_t)map_row(mode, n0 + n) * K + k0 + 8 * ch) = o; }
    LDS_WAIT(); asm volatile("" ::: "memory");
}
constexpr int I_G = 32 * 128, I_U = 32 * 128, I_D = 32 * 128, I_IN = 16 * 40, I_OUT = 16 * 16, I_PG = 16 * 16, I_PP = 4 * 16;
constexpr int CONV_ITEMS = I_G + I_U + I_D + I_IN + I_OUT + I_PG + I_PP;
__device__ __forceinline__ void conv_item(Frame& F, LAS unsigned char* scr, int it) {
    unsigned char* ws = F.ws; int r = it;
    if (r < I_IN) { p0_transpose_item(F.in[3], D, NIN, (bf16*)(ws + WS_WIN), 1, nullptr, scr, r, F.lane); return; } r -= I_IN;
    if (r < I_OUT) { p0_transpose_item(F.in[8], D, D, (bf16*)(ws + WS_WOUT), 0, nullptr, scr, r, F.lane); return; } r -= I_OUT;
    if (r < I_G) { const int e = r >> 7; p0_transpose_item(F.in[14] + (size_t)e * D * FE, D, FE, (bf16*)(ws + WS_WGU) + (size_t)e * 1024 * 1024, 2, F.in[9], scr, r & 127, F.lane); return; } r -= I_G;
    if (r < I_U) { const int e = r >> 7; p0_transpose_item(F.in[15] + (size_t)e * D * FE, D, FE, (bf16*)(ws + WS_WGU) + (size_t)e * 1024 * 1024, 3, F.in[9], scr, r & 127, F.lane); return; } r -= I_U;
    if (r < I_D) { const int e = r >> 7; p0_transpose_item(F.in[16] + (size_t)e * FE * D, FE, D, (bf16*)(ws + WS_WDN) + (size_t)e * 1024 * 512, 0, nullptr, scr, r & 127, F.lane); return; } r -= I_D;
    if (r < I_PG) { p0_transpose_item(F.in[18], D, D, (bf16*)(ws + WS_WPG), 0, F.in[17], scr, r, F.lane); return; } r -= I_PG;
    p0_transpose_item(F.in[19], PLE, D, (bf16*)(ws + WS_WPP), 0, nullptr, scr, r, F.lane);
}
__device__ __forceinline__ void p0_prologue(Frame& F) {
    LAS unsigned char* scr = F.lds + F.wave * 16384;
    const int gw = F.vcu * NWAVES + F.wave, NGW = F.G * NWAVES;
    unsigned char* ws = F.ws;
    {
        const float* x = F.in[0]; const float* g = F.in[2]; bf16* XN = (bf16*)(ws + WS_XN);
        f32x4 gv[4];
#pragma unroll
        for (int j = 0; j < 4; ++j) gv[j] = *((const f32x4*)g + F.lane + 64 * j);
        for (int m = gw * 4; m < T; m += NGW * 4) {
            f32x4 v[4][4]; float s[4];
#pragma unroll
            for (int rr = 0; rr < 4; ++rr) { const f32x4* xr = (const f32x4*)(x + (size_t)(m + rr) * D) + F.lane;
#pragma unroll
                for (int j = 0; j < 4; ++j) v[rr][j] = xr[64 * j]; }
#pragma unroll
            for (int rr = 0; rr < 4; ++rr) { float a = 0.f;
#pragma unroll
                for (int j = 0; j < 4; ++j) a += (v[rr][j].x * v[rr][j].x + v[rr][j].y * v[rr][j].y) + (v[rr][j].z * v[rr][j].z + v[rr][j].w * v[rr][j].w);
                s[rr] = a; }
#pragma unroll
            for (int o = 1; o < 64; o <<= 1) {
#pragma unroll
                for (int rr = 0; rr < 4; ++rr) s[rr] += __shfl_xor(s[rr], o); }
#pragma unroll
            for (int rr = 0; rr < 4; ++rr) { const float rstd = 1.0f / sqrtf(s[rr] * (1.f / D) + EPS); u32x2* o8 = (u32x2*)(XN + (size_t)(m + rr) * D) + F.lane;
#pragma unroll
                for (int j = 0; j < 4; ++j) { const f32x4 y = v[rr][j] * rstd * gv[j]; u32x2 w; w.x = cvt_pk_bf16(y.x, y.y); w.y = cvt_pk_bf16(y.z, y.w); o8[64 * j] = w; } }
        }
    }
    for (int it = gw; it < CONV_ITEMS; it += NGW) conv_item(F, scr, it);
    {
        const float* p = F.in[1]; bf16* PB = (bf16*)(ws + WS_PBF);
        const int gt = F.vcu * NTHR + F.tid, NGT = F.G * NTHR;
#pragma unroll 4
        for (int i = gt; i < T * PLE / 8; i += NGT) { const f32x4 a = *((const f32x4*)p + 2 * i), b = *((const f32x4*)p + 2 * i + 1);
            u32x4 w; w.x = cvt_pk_bf16(a.x, a.y); w.y = cvt_pk_bf16(a.z, a.w); w.z = cvt_pk_bf16(b.x, b.y); w.w = cvt_pk_bf16(b.z, b.w); *((u32x4*)PB + i) = w; }
        bf16* WRH = (bf16*)(ws + WS_WR); bf16* WRL = WRH + 48 * 1024;
        const float* gf = F.in[9]; const float* wg = F.in[10]; const float* wrt = F.in[12];
        for (int i = gt; i < 48 * 1024; i += NGT) { const int o = i >> 10, k = i & 1023; float v = 0.f;
            if (o < 4) v = wg[k * 4 + o]; else if (o < 36) { const int gg = (o - 4) >> 3, e = (o - 4) & 7; v = wrt[((size_t)gg * D + k) * 8 + e]; }
            v *= gf[k]; const unsigned h = cvt_pk_bf16(v, 0.f) & 0xffffu; const float hf = bf_lo(h); const unsigned l = cvt_pk_bf16(v - hf, 0.f) & 0xffffu;
            WRH[i] = (bf16)h; WRL[i] = (bf16)l; }
    }
}

__device__ __forceinline__ void dense_rows(const Unit& u, int K, unsigned (&vA)[2][2], const int (&R)[2], const int (&C)[2]) {
#pragma unroll
    for (int h = 0; h < 2; ++h)
#pragma unroll
        for (int i = 0; i < 2; ++i) vA[h][i] = (unsigned)((u.base + h * 128 + R[i]) * K + C[i]) * 2u;
}
struct ProbInProj {
    static constexpr bool PERM = true;
    const bf16* A; const bf16* Bt; int K; bf16* Z; pg8::StaticOrder S;
    __device__ bool next(int i, Unit& u) const { return S.next(i, u); }
    __device__ const char* b_base(const Unit& u) const { return (const char*)Bt + (size_t)u.pn * 256 * K * 2; }
    __device__ void a_rows(const Unit& u, unsigned (&vA)[2][2], const int (&R)[2], const int (&C)[2]) const { dense_rows(u, K, vA, R, C); }
    __device__ __forceinline__ void epi(const f32x4 (&acc)[2][2][4][2], const Unit& u, int wr, int wc, int fr, int fq) const {
        const int row0 = u.pm * 256 + wr * 64 + fr, pn = u.pn;
        if (pn >= 2 && pn < 6) {
            const int col0 = 512 + (pn - 2) * 128 + wc * 32 + 8 * fq;
#pragma unroll
            for (int ai = 0; ai < 2; ++ai)
#pragma unroll
                for (int m = 0; m < 4; ++m) { bf16* rowp = Z + (size_t)(row0 + ai * 128 + m * 16) * ZW + col0;
                    const f32x4 v0 = acc[ai][0][m][0] * acc[ai][1][m][0], v1 = acc[ai][0][m][1] * acc[ai][1][m][1];
                    u32x4 w; w.x = cvt_pk_bf16(v0[0], v0[1]); w.y = cvt_pk_bf16(v0[2], v0[3]); w.z = cvt_pk_bf16(v1[0], v1[1]); w.w = cvt_pk_bf16(v1[2], v1[3]);
                    *(u32x4*)rowp = w; }
        } else {
            const bool act = pn >= 6; const int colt = pn < 2 ? pn * 256 : 1024 + (pn - 6) * 256; const int col0 = colt + wc * 32 + 8 * fq;
#pragma unroll
            for (int ai = 0; ai < 2; ++ai)
#pragma unroll
                for (int m = 0; m < 4; ++m) { bf16* rowp = Z + (size_t)(row0 + ai * 128 + m * 16) * ZW + col0;
#pragma unroll
                    for (int bj = 0; bj < 2; ++bj) { f32x4 v0 = acc[ai][bj][m][0], v1 = acc[ai][bj][m][1];
                        if (act) {
#pragma unroll
                            for (int i = 0; i < 4; ++i) { v0[i] = gelu_tanh(v0[i]); v1[i] = gelu_tanh(v1[i]); } }
                        u32x4 w; w.x = cvt_pk_bf16(v0[0], v0[1]); w.y = cvt_pk_bf16(v0[2], v0[3]); w.z = cvt_pk_bf16(v1[0], v1[1]); w.w = cvt_pk_bf16(v1[2], v1[3]);
                        *(u32x4*)(rowp + bj * 128) = w; } }
        }
    }
};
struct ProbOutProj {
    static constexpr bool PERM = false;
    const bf16* A; const bf16* Bt; int K; const float* x; float* out; pg8::StaticOrder S;
    __device__ bool next(int i, Unit& u) const { return S.next(i, u); }
    __device__ const char* b_base(const Unit& u) const { return (const char*)Bt + (size_t)u.pn * 256 * K * 2; }
    __device__ void a_rows(const Unit& u, unsigned (&vA)[2][2], const int (&R)[2], const int (&C)[2]) const { dense_rows(u, K, vA, R, C); }
    __device__ __forceinline__ void epi(const f32x4 (&acc)[2][2][4][2], const Unit& u, int wr, int wc, int fr, int fq) const {
        const int row0 = u.pm * 256 + wr * 64 + fr, col0 = u.pn * 256 + wc * 32 + 4 * fq;
#pragma unroll
        for (int ai = 0; ai < 2; ++ai)
#pragma unroll
            for (int m = 0; m < 4; ++m) { const size_t off = (size_t)(row0 + ai * 128 + m * 16) * D + col0;
#pragma unroll
                for (int bj = 0; bj < 2; ++bj)
#pragma unroll
                    for (int n = 0; n < 2; ++n) { const size_t o = off + bj * 128 + n * 16; *(f32x4*)(out + o) = *(const f32x4*)(x + o) + acc[ai][bj][m][n]; }
                if (m & 1) asm volatile("" ::: "memory"); }
    }
};
struct GroupSched {
    const LAS int* tab; int G, c;
    __device__ bool next(int i, Unit& u) const {
        const int L = i * G + c; if (L >= tab[32]) return false;
        int e = 0;
#pragma unroll 1
        for (int j = 1; j < 32; ++j) if (L >= tab[j]) e = j;
        const int rem = L - tab[e]; u.e = e; u.pm = rem >> 2; u.pn = rem & 3; const int n = tab[80 + e] - u.pm * 256; u.rows = n < 256 ? n : 256; u.base = tab[40 + e] + u.pm * 256; return true;
    }
};
struct ProbGateUp {
    static constexpr bool PERM = true;
    const bf16* A; const bf16* Bt; int K; const PInfo* pinfo; bf16* Hid; GroupSched S;
    __device__ bool next(int i, Unit& u) const { return S.next(i, u); }
    __device__ const char* b_base(const Unit& u) const { return (const char*)Bt + ((size_t)u.e * 1024 + (size_t)u.pn * 256) * K * 2; }
    __device__ void a_rows(const Unit& u, unsigned (&vA)[2][2], const int (&R)[2], const int (&C)[2]) const {
        const PInfo* pi = pinfo + (size_t)u.e * CAP + u.pm * 256;
#pragma unroll
        for (int h = 0; h < 2; ++h)
#pragma unroll
            for (int i = 0; i < 2; ++i) { const int r = h * 128 + R[i]; const int tok = r < u.rows ? (pi[r].dest >> 1) : 0; vA[h][i] = (unsigned)(tok * K + C[i]) * 2u; }
    }
    __device__ __forceinline__ void epi(const f32x4 (&acc)[2][2][4][2], const Unit& u, int wr, int wc, int fr, int fq) const {
        const PInfo* pi = pinfo + (size_t)u.e * CAP + u.pm * 256;
        const int col0 = u.pn * 128 + wc * 32 + 8 * fq;
#pragma unroll
        for (int ai = 0; ai < 2; ++ai)
#pragma unroll
            for (int m = 0; m < 4; ++m) { const int r = ai * 128 + wr * 64 + m * 16 + fr;
                if (r < u.rows) { const f32x4 inf = *(const f32x4*)(pi + r); const float w = inf.y, rs = inf.z;
                    float h[8];
#pragma unroll
                    for (int n = 0; n < 2; ++n)
#pragma unroll
                        for (int i = 0; i < 4; ++i) { const float a = rs * acc[ai][0][m][n][i], b = rs * acc[ai][1][m][n][i]; h[n * 4 + i] = a * sigmoidf_(a) * b * w; }
                    u32x4 o; o.x = cvt_pk_bf16(h[0], h[1]); o.y = cvt_pk_bf16(h[2], h[3]); o.z = cvt_pk_bf16(h[4], h[5]); o.w = cvt_pk_bf16(h[6], h[7]);
                    *(u32x4*)(Hid + (size_t)(u.base + r) * FE + col0) = o; } }
    }
};
struct ProbDown {
    static constexpr bool PERM = true;
    const bf16* A; const bf16* Bt; int K; const PInfo* pinfo; bf16* Yp; GroupSched S;
    __device__ bool next(int i, Unit& u) const { return S.next(i, u); }
    __device__ const char* b_base(const Unit& u) const { return (const char*)Bt + ((size_t)u.e * 1024 + (size_t)u.pn * 256) * K * 2; }
    __device__ void a_rows(const Unit& u, unsigned (&vA)[2][2], const int (&R)[2], const int (&C)[2]) const { dense_rows(u, K, vA, R, C); }
    __device__ __forceinline__ void epi(const f32x4 (&acc)[2][2][4][2], const Unit& u, int wr, int wc, int fr, int fq) const {
        const PInfo* pi = pinfo + (size_t)u.e * CAP + u.pm * 256;
        const int col0 = u.pn * 256 + wc * 32 + 8 * fq;
#pragma unroll
        for (int ai = 0; ai < 2; ++ai)
#pragma unroll
            for (int m = 0; m < 4; ++m) { const int r = ai * 128 + wr * 64 + m * 16 + fr;
                if (r < u.rows) { const int dest = pi[r].dest; bf16* rowp = Yp + (size_t)dest * D + col0;
#pragma unroll
                    for (int bj = 0; bj < 2; ++bj) { const f32x4 v0 = acc[ai][bj][m][0], v1 = acc[ai][bj][m][1];
                        u32x4 o; o.x = cvt_pk_bf16(v0[0], v0[1]); o.y = cvt_pk_bf16(v0[2], v0[3]); o.z = cvt_pk_bf16(v1[0], v1[1]); o.w = cvt_pk_bf16(v1[2], v1[3]);
                        *(u32x4*)(rowp + bj * 128) = o; } } }
    }
};
struct ProbPP {
    static constexpr bool PERM = true;
    const bf16* A; const bf16* Bt; int K; bf16* O; pg8::StaticOrder S;
    __device__ bool next(int i, Unit& u) const { return S.next(i, u); }
    __device__ const char* b_base(const Unit& u) const { return (const char*)Bt + (size_t)u.pn * 256 * K * 2; }
    __device__ void a_rows(const Unit& u, unsigned (&vA)[2][2], const int (&R)[2], const int (&C)[2]) const { dense_rows(u, K, vA, R, C); }
    __device__ __forceinline__ void epi(const f32x4 (&acc)[2][2][4][2], const Unit& u, int wr, int wc, int fr, int fq) const {
        const int row0 = u.pm * 256 + wr * 64 + fr, col0 = u.pn * 256 + wc * 32 + 8 * fq;
#pragma unroll
        for (int ai = 0; ai < 2; ++ai)
#pragma unroll
            for (int m = 0; m < 4; ++m) { bf16* rowp = O + (size_t)(row0 + ai * 128 + m * 16) * D + col0;
#pragma unroll
                for (int bj = 0; bj < 2; ++bj) { const f32x4 v0 = acc[ai][bj][m][0], v1 = acc[ai][bj][m][1];
                    u32x4 o; o.x = cvt_pk_bf16(v0[0], v0[1]); o.y = cvt_pk_bf16(v0[2], v0[3]); o.z = cvt_pk_bf16(v1[0], v1[1]); o.w = cvt_pk_bf16(v1[2], v1[3]);
                    *(u32x4*)(rowp + bj * 128) = o; } }
    }
};
struct ProbPleGate {
    static constexpr bool PERM = false;
    const bf16* A; const bf16* Bt; int K; const bf16* PP; const float* rstd; float* out; float* outw; pg8::StaticOrder S;
    __device__ bool next(int i, Unit& u) const { return S.next(i, u); }
    __device__ const char* b_base(const Unit& u) const { return (const char*)Bt + (size_t)u.pn * 256 * K * 2; }
    __device__ void a_rows(const Unit& u, unsigned (&vA)[2][2], const int (&R)[2], const int (&C)[2]) const { dense_rows(u, K, vA, R, C); }
    __device__ __forceinline__ void epi(const f32x4 (&acc)[2][2][4][2], const Unit& u, int wr, int wc, int fr, int fq) const {
        const int row0 = u.pm * 256 + wr * 64 + fr, col0 = u.pn * 256 + wc * 32 + 4 * fq;
#pragma unroll
        for (int ai = 0; ai < 2; ++ai)
#pragma unroll
            for (int m = 0; m < 4; ++m) { const int row = row0 + ai * 128 + m * 16; const size_t off = (size_t)row * D + col0; const float rs = rstd[row];
#pragma unroll
                for (int bj = 0; bj < 2; ++bj)
#pragma unroll
                    for (int n = 0; n < 2; ++n) { const size_t o = off + bj * 128 + n * 16; const f32x4 x2 = *(const f32x4*)(out + o); const u32x2 pp = *(const u32x2*)(PP + o);
                        const f32x4 a = acc[ai][bj][m][n]; f32x4 r;
                        r[0] = x2[0] + sigmoidf_(rs * a[0]) * bf_lo(pp.x); r[1] = x2[1] + sigmoidf_(rs * a[1]) * bf_hi(pp.x);
                        r[2] = x2[2] + sigmoidf_(rs * a[2]) * bf_lo(pp.y); r[3] = x2[3] + sigmoidf_(rs * a[3]) * bf_hi(pp.y);
                        *(f32x4*)(outw + o) = r; }
                if (m & 1) asm volatile("" ::: "memory"); }
    }
};

__device__ __forceinline__ void p2_mixer(Frame& F) {
    const bf16* Z = (const bf16*)(F.ws + WS_Z); bf16* Y = (bf16*)(F.ws + WS_Y);
    const float* wconv = F.in[4]; const float* gsgu = F.in[5]; const float* wsp = F.in[6]; const float* bsp = F.in[7];
    LAS unsigned char* lds = F.lds;
    LAS f32x2* stat = (LAS f32x2*)lds;
    LAS bf16* vT = (LAS bf16*)(lds + 1024);
    constexpr int VS = 136;
    const int tid = F.tid, lane = F.lane, wave = F.wave;
    for (int u = F.vcu; u < 256; u += F.G) {
        const int ci = u >> 1, hg = u & 1, t0 = ci * CH;
        {
            const int cg = tid & 31, rg = tid >> 5, col = hg * 256 + cg * 8, r0 = t0 + rg * 8;
            float w0[8], w1[8], w2[8];
#pragma unroll
            for (int j = 0; j < 2; ++j) { const f32x4 a = *(const f32x4*)(wconv + col + 4 * j), b = *(const f32x4*)(wconv + 512 + col + 4 * j), c = *(const f32x4*)(wconv + 1024 + col + 4 * j);
#pragma unroll
                for (int i = 0; i < 4; ++i) { w0[4 * j + i] = a[i]; w1[4 * j + i] = b[i]; w2[4 * j + i] = c[i]; } }
            u32x4 p2 = (u32x4){0u, 0u, 0u, 0u}, p1 = (u32x4){0u, 0u, 0u, 0u};
            const int sp = r0 & (SEQ - 1);
            if (sp >= 2) { p2 = *(const u32x4*)(Z + (size_t)(r0 - 2) * ZW + 512 + col); p1 = *(const u32x4*)(Z + (size_t)(r0 - 1) * ZW + 512 + col); }
#pragma unroll
            for (int i = 0; i < 8; ++i) { const size_t ro = (size_t)(r0 + i) * ZW;
                const u32x4 cz = *(const u32x4*)(Z + ro + 512 + col), bb = *(const u32x4*)(Z + ro + col);
                u32x4 o;
#pragma unroll
                for (int q = 0; q < 4; ++q) { const float ylo = bf_lo(bb[q]) * (w0[2 * q] * bf_lo(p2[q]) + w1[2 * q] * bf_lo(p1[q]) + w2[2 * q] * bf_lo(cz[q]));
                    const float yhi = bf_hi(bb[q]) * (w0[2 * q + 1] * bf_hi(p2[q]) + w1[2 * q + 1] * bf_hi(p1[q]) + w2[2 * q + 1] * bf_hi(cz[q])); o[q] = cvt_pk_bf16(ylo, yhi); }
                *(u32x4*)(Y + (size_t)(r0 + i) * D + col) = o; p2 = p1; p1 = cz; }
        }
        {
            const int row = tid >> 2, q = tid & 3; const bf16* vp = Z + (size_t)(t0 + row) * ZW + 1536 + q * 128;
            float s = 0.f, ss = 0.f;
#pragma unroll
            for (int j = 0; j < 16; ++j) { const u32x4 v = *(const u32x4*)(vp + 8 * j);
#pragma unroll
                for (int i = 0; i < 4; ++i) { const float a = bf_lo(v[i]), b = bf_hi(v[i]); s += a + b; ss += a * a + b * b; } }
            s += __shfl_xor(s, 1); s += __shfl_xor(s, 2); ss += __shfl_xor(ss, 1); ss += __shfl_xor(ss, 2);
            const float mean = s * (1.f / 512.f); const float var = fmaxf(ss * (1.f / 512.f) - mean * mean, 0.f);
            if (q == 0) stat[row] = (f32x2){mean, 1.0f / sqrtf(var + EPS)};
        }
        LDS_WAIT(); __syncthreads();
        {
            const int s = tid & 127, hl = tid >> 7; const f32x2 st = stat[s]; const int cbase = (4 * hg + hl) * 64;
            const bf16* vp = Z + (size_t)(t0 + s) * ZW + 1536 + cbase;
#pragma unroll
            for (int dg = 0; dg < 8; ++dg) { const u32x4 v = *(const u32x4*)(vp + 8 * dg); const f32x4 g0 = *(const f32x4*)(gsgu + cbase + 8 * dg), g1 = *(const f32x4*)(gsgu + cbase + 8 * dg + 4);
                float y[8];
                y[0] = (bf_lo(v.x) - st.x) * st.y * g0[0]; y[1] = (bf_hi(v.x) - st.x) * st.y * g0[1]; y[2] = (bf_lo(v.y) - st.x) * st.y * g0[2]; y[3] = (bf_hi(v.y) - st.x) * st.y * g0[3];
                y[4] = (bf_lo(v.z) - st.x) * st.y * g1[0]; y[5] = (bf_hi(v.z) - st.x) * st.y * g1[1]; y[6] = (bf_lo(v.w) - st.x) * st.y * g1[2]; y[7] = (bf_hi(v.w) - st.x) * st.y * g1[3];
#pragma unroll
                for (int j = 0; j < 8; j += 2) { const unsigned pk = cvt_pk_bf16(y[j], y[j + 1]);
                    vT[(hl * 64 + dg * 8 + j) * VS + s] = (bf16)(pk & 0xffffu); vT[(hl * 64 + dg * 8 + j + 1) * VS + s] = (bf16)(pk >> 16); } }
        }
        LDS_WAIT(); __syncthreads();
        {
            const int hl = wave >> 1, th = wave & 1, h = 4 * hg + hl, fr = lane & 15, fq = lane >> 4;
#pragma unroll 1
            for (int tt = 0; tt < 4; ++tt) {
                const int T0 = 64 * th + 16 * tt, tl = T0 + fr, ksteps = (T0 + 16 + 31) >> 5;
                f32x4 acc[4];
#pragma unroll
                for (int dt = 0; dt < 4; ++dt) acc[dt] = (f32x4){0.f, 0.f, 0.f, 0.f};
                const float* wrow = wsp + ((size_t)h * CH + tl) * CH;
#pragma unroll 1
                for (int ks = 0; ks < ksteps; ++ks) {
                    const int s0 = 32 * ks + 8 * fq; const f32x4 a = *(const f32x4*)(wrow + s0), b = *(const f32x4*)(wrow + s0 + 4);
                    float wv[8] = {a[0], a[1], a[2], a[3], b[0], b[1], b[2], b[3]};
#pragma unroll
                    for (int j = 0; j < 8; ++j) if (s0 + j > tl) wv[j] = 0.f;
                    u32x4 wp; wp.x = cvt_pk_bf16(wv[0], wv[1]); wp.y = cvt_pk_bf16(wv[2], wv[3]); wp.z = cvt_pk_bf16(wv[4], wv[5]); wp.w = cvt_pk_bf16(wv[6], wv[7]);
                    const bf16x8 bfrag = __builtin_bit_cast(bf16x8, wp);
#pragma unroll
                    for (int dt = 0; dt < 4; ++dt) { const bf16x8 afrag = *(const LAS bf16x8*)(vT + (hl * 64 + 16 * dt + fr) * VS + s0);
                        acc[dt] = __builtin_amdgcn_mfma_f32_16x16x32_bf16(afrag, bfrag, acc[dt], 0, 0, 0); }
                }
                const float bias = bsp[h * CH + tl]; const size_t trow = (size_t)(t0 + tl);
#pragma unroll
                for (int dt = 0; dt < 4; ++dt) { const int c = h * 64 + 16 * dt + 4 * fq; const u32x2 uu = *(const u32x2*)(Z + trow * ZW + 1024 + c);
                    const float y0 = bf_lo(uu.x) * (acc[dt][0] + bias), y1 = bf_hi(uu.x) * (acc[dt][1] + bias), y2 = bf_lo(uu.y) * (acc[dt][2] + bias), y3 = bf_hi(uu.y) * (acc[dt][3] + bias);
                    u32x2 o; o.x = cvt_pk_bf16(y0, y1); o.y = cvt_pk_bf16(y2, y3); *(u32x2*)(Y + trow * D + 512 + c) = o; }
            }
        }
        __syncthreads();
    }
}

__device__ __forceinline__ void p4_route(Frame& F, const bool dry = false) {
    const float* X1 = F.out; bf16* XB = (bf16*)(F.ws + WS_XN);
    const bf16* WRH = (const bf16*)(F.ws + WS_WR); const bf16* WRL = WRH + 48 * 1024;
    PInfo* pinfo = (PInfo*)(F.ws + WS_PINFO);
    unsigned* gcnt = F.ctl + CW_CNT;
    const float* bgrp = F.in[11]; const float* brt = F.in[13];
    LAS unsigned char* lds = F.lds;
    LAS float* part = (LAS float*)lds;
    LAS float* ssq = (LAS float*)(lds + 8 * 64 * 49 * 4);
    LAS int* lcnt = (LAS int*)(lds + 8 * 64 * 49 * 4 + 2048);
    LAS int* lbase = lcnt + 32;
    const int tid = F.tid, lane = F.lane, w = F.wave, fr = lane & 15, fq = lane >> 4;
    for (int unit = F.vcu; unit < T / 64; unit += F.G) {
        const int r0 = unit * 64;
        if (tid < 32) lcnt[tid] = 0;
        f32x4 acc[4][3]; float sq[4];
#pragma unroll
        for (int rt = 0; rt < 4; ++rt) { sq[rt] = 0.f;
#pragma unroll
            for (int ct = 0; ct < 3; ++ct) acc[rt][ct] = (f32x4){0.f, 0.f, 0.f, 0.f}; }
#pragma unroll 1
        for (int ks = 0; ks < 4; ++ks) {
            const int k = 128 * w + 32 * ks + 8 * fq;
            bf16x8 bh[3], bl[3];
#pragma unroll
            for (int ct = 0; ct < 3; ++ct) { bh[ct] = *(const bf16x8*)(WRH + (size_t)(16 * ct + fr) * D + k); bl[ct] = *(const bf16x8*)(WRL + (size_t)(16 * ct + fr) * D + k); }
#pragma unroll
            for (int rt = 0; rt < 4; ++rt) {
                const size_t off = (size_t)(r0 + 16 * rt + fr) * D + k;
                const f32x4 x0 = *(const f32x4*)(X1 + off), x1 = *(const f32x4*)(X1 + off + 4);
                sq[rt] += (x0[0] * x0[0] + x0[1] * x0[1]) + (x0[2] * x0[2] + x0[3] * x0[3]) + (x1[0] * x1[0] + x1[1] * x1[1]) + (x1[2] * x1[2] + x1[3] * x1[3]);
                u32x4 hi; hi.x = cvt_pk_bf16(x0[0], x0[1]); hi.y = cvt_pk_bf16(x0[2], x0[3]); hi.z = cvt_pk_bf16(x1[0], x1[1]); hi.w = cvt_pk_bf16(x1[2], x1[3]);
                u32x4 lo; lo.x = cvt_pk_bf16(x0[0] - bf_lo(hi.x), x0[1] - bf_hi(hi.x)); lo.y = cvt_pk_bf16(x0[2] - bf_lo(hi.y), x0[3] - bf_hi(hi.y));
                lo.z = cvt_pk_bf16(x1[0] - bf_lo(hi.z), x1[1] - bf_hi(hi.z)); lo.w = cvt_pk_bf16(x1[2] - bf_lo(hi.w), x1[3] - bf_hi(hi.w));
                *(u32x4*)(XB + off) = hi;
                const bf16x8 ah = __builtin_bit_cast(bf16x8, hi), al = __builtin_bit_cast(bf16x8, lo);
#pragma unroll
                for (int ct = 0; ct < 3; ++ct) {
                    acc[rt][ct] = __builtin_amdgcn_mfma_f32_16x16x32_bf16(ah, bh[ct], acc[rt][ct], 0, 0, 0);
                    acc[rt][ct] = __builtin_amdgcn_mfma_f32_16x16x32_bf16(al, bh[ct], acc[rt][ct], 0, 0, 0);
                    acc[rt][ct] = __builtin_amdgcn_mfma_f32_16x16x32_bf16(ah, bl[ct], acc[rt][ct], 0, 0, 0); }
            }
        }
#pragma unroll
        for (int rt = 0; rt < 4; ++rt) {
#pragma unroll
            for (int ct = 0; ct < 3; ++ct)
#pragma unroll
                for (int i = 0; i < 4; ++i) part[(w * 64 + 16 * rt + 4 * fq + i) * 49 + 16 * ct + fr] = acc[rt][ct][i];
            float s = sq[rt]; s += __shfl_xor(s, 16); s += __shfl_xor(s, 32);
            if (fq == 0) ssq[w * 64 + 16 * rt + fr] = s; }
        LDS_WAIT(); __syncthreads();
        int e1 = 0, e2 = 0, lp1 = 0, lp2 = 0; float w1 = 0.f, w2 = 0.f, rstd = 0.f;
        if (tid < 64) {
            const int row = tid;
            float ss = 0.f;
#pragma unroll
            for (int ww = 0; ww < 8; ++ww) ss += ssq[ww * 64 + row];
            rstd = 1.0f / sqrtf(ss * (1.f / D) + EPS);
            float gl[4];
#pragma unroll
            for (int o = 0; o < 4; ++o) { float s = 0.f;
#pragma unroll
                for (int ww = 0; ww < 8; ++ww) s += part[(ww * 64 + row) * 49 + o];
                gl[o] = rstd * s + bgrp[o]; }
            int gi = 0; float gm = gl[0];
#pragma unroll
            for (int o = 1; o < 4; ++o) if (gl[o] > gm) { gm = gl[o]; gi = o; }
            float gsum = 0.f;
#pragma unroll
            for (int o = 0; o < 4; ++o) gsum += __expf(gl[o] - gm);
            const float gw = 1.0f / gsum;
            float v1 = -INFINITY, v2 = -INFINITY; int i1 = 0, i2 = 0;
#pragma unroll
            for (int e = 0; e < 8; ++e) { float s = 0.f;
#pragma unroll
                for (int ww = 0; ww < 8; ++ww) s += part[(ww * 64 + row) * 49 + 4 + gi * 8 + e];
                const float v = rstd * s + brt[gi * 8 + e];
                if (v > v1) { v2 = v1; i2 = i1; v1 = v; i1 = e; } else if (v > v2) { v2 = v; i2 = e; } }
            const float ex = __expf(v2 - v1); const float p1 = 1.0f / (1.0f + ex);
            w1 = gw * p1; w2 = gw * (ex * p1);
            e1 = gi * 8 + i1; e2 = gi * 8 + i2;
            if (!dry) { lp1 = atomicAdd((int*)&lcnt[e1], 1); lp2 = atomicAdd((int*)&lcnt[e2], 1); }
        }
        LDS_WAIT(); __syncthreads();
        if (tid < 32) { const int c = lcnt[tid]; lbase[tid] = c > 0 ? (int)__hip_atomic_fetch_add(gcnt + tid, (unsigned)c, __ATOMIC_RELAXED, __HIP_MEMORY_SCOPE_AGENT) : 0; }
        LDS_WAIT(); __syncthreads();
        if (tid < 64 && !dry) {
            const int t = r0 + tid;
            PInfo a; a.dest = 2 * t; a.w = w1; a.rstd = rstd; a.pad = 0; PInfo b; b.dest = 2 * t + 1; b.w = w2; b.rstd = rstd; b.pad = 0;
            *(u32x4*)(pinfo + (size_t)e1 * CAP + lbase[e1] + lp1) = __builtin_bit_cast(u32x4, a);
            *(u32x4*)(pinfo + (size_t)e2 * CAP + lbase[e2] + lp2) = __builtin_bit_cast(u32x4, b);
        }
        __syncthreads();
    }
}

__device__ __forceinline__ void build_tables(Frame& F) {
    LAS int* tab = (LAS int*)(F.lds + TAB_OFF);
    if (F.tid == 0) {
        int ts = 0, ho = 0;
        for (int e = 0; e < NE; ++e) { const int c = (int)__hip_atomic_load(F.ctl + CW_CNT + e, __ATOMIC_RELAXED, __HIP_MEMORY_SCOPE_AGENT); tab[e] = ts; tab[40 + e] = ho; tab[80 + e] = c; ts += ((c + 255) >> 8) * 4; ho += c; }
        tab[32] = ts; tab[72] = ho;
    }
    LDS_WAIT(); __syncthreads();
}

__device__ __forceinline__ void p7_combine(Frame& F, const bool dry = false) {
    float* X = F.out; const bf16* Yp = (const bf16*)(F.ws + WS_Z); bf16* XB = (bf16*)(F.ws + (dry ? WS_WDN : WS_XN)); float* rstd2 = (float*)(F.ws + WS_RSTD);
    float* XW = dry ? (float*)(F.ws + WS_WGU) : X;
    const int gw = F.vcu * NWAVES + F.wave, NGW = F.G * NWAVES;
    for (int m = gw; m < T; m += NGW) {
        f32x4* xr = (f32x4*)(X + (size_t)m * D) + F.lane; f32x4* xw = (f32x4*)(XW + (size_t)m * D) + F.lane; const u32x2* y0 = (const u32x2*)(Yp + (size_t)(2 * m) * D) + F.lane; const u32x2* y1 = (const u32x2*)(Yp + (size_t)(2 * m + 1) * D) + F.lane;
        u32x2* ob = (u32x2*)(XB + (size_t)m * D) + F.lane;
        f32x4 v[4]; float s = 0.f;
#pragma unroll
        for (int j = 0; j < 4; ++j) { v[j] = xr[64 * j]; const u32x2 a = y0[64 * j], b = y1[64 * j];
            v[j].x += bf_lo(a.x) + bf_lo(b.x); v[j].y += bf_hi(a.x) + bf_hi(b.x); v[j].z += bf_lo(a.y) + bf_lo(b.y); v[j].w += bf_hi(a.y) + bf_hi(b.y);
            s += (v[j].x * v[j].x + v[j].y * v[j].y) + (v[j].z * v[j].z + v[j].w * v[j].w); }
        s = wave_sum(s);
#pragma unroll
        for (int j = 0; j < 4; ++j) { xw[64 * j] = v[j]; u32x2 w; w.x = cvt_pk_bf16(v[j].x, v[j].y); w.y = cvt_pk_bf16(v[j].z, v[j].w); ob[64 * j] = w; }
        if (F.lane == 0) rstd2[m] = 1.0f / sqrtf(s * (1.f / D) + EPS);
    }
}
__device__ __forceinline__ void p10_final(Frame& F, const bool dry = false) {
    float* X = F.out; const float* g = F.in[20]; float* XW = dry ? (float*)(F.ws + WS_Z) : X;
    const int gw = F.vcu * NWAVES + F.wave, NGW = F.G * NWAVES;
    f32x4 gv[4];
#pragma unroll
    for (int j = 0; j < 4; ++j) gv[j] = *((const f32x4*)g + F.lane + 64 * j);
    for (int m = gw; m < T; m += NGW) {
        f32x4* xr = (f32x4*)(X + (size_t)m * D) + F.lane; f32x4* xw = (f32x4*)(XW + (size_t)m * D) + F.lane;
        f32x4 v[4]; float s = 0.f;
#pragma unroll
        for (int j = 0; j < 4; ++j) { v[j] = xr[64 * j]; s += (v[j].x * v[j].x + v[j].y * v[j].y) + (v[j].z * v[j].z + v[j].w * v[j].w); }
        const float rstd = 1.0f / sqrtf(wave_sum(s) * (1.f / D) + EPS);
#pragma unroll
        for (int j = 0; j < 4; ++j) xw[64 * j] = v[j] * rstd * gv[j];
    }
}

struct Args { const float* in[21]; float* out; unsigned char* ws; int ph_lo, ph_hi, li, pad; };
constexpr int N_PHASES = 11;

__global__ void __launch_bounds__(NTHR, 2) fwd_kernel(Args args) {
    extern __shared__ __attribute__((aligned(16))) unsigned char lds_raw[];
    Frame F;
    F.lds = (LAS unsigned char*)lds_raw;
    F.tid = threadIdx.x; F.lane = F.tid & 63; F.wave = __builtin_amdgcn_readfirstlane(F.tid >> 6);
    F.G = gridDim.x; { const int bx = blockIdx.x; F.vcu = (F.G % 8 == 0) ? (bx % 8) * (F.G / 8) + bx / 8 : bx; }
#pragma unroll
    for (int i = 0; i < 21; ++i) F.in[i] = args.in[i];
    F.out = args.out; F.ws = args.ws; F.ctl = (unsigned*)(args.ws + WS_CTL);
    volatile LAS unsigned* MISC = (volatile LAS unsigned*)(F.lds + LDSCTL_OFF);
    for (int u = F.tid; u < 64; u += NTHR) MISC[u] = 0u;
    __syncthreads();
    const int lo = args.ph_lo, hi = args.ph_hi;
    XcdBarrier bar; bar.bar = F.ctl + CW_BAR; bar.x = 0; bar.st = nullptr;
    if (hi - lo > 1) bar = xcd_barrier_post(F.ctl + CW_BAR, MISC + 8);
#define IN(k) (lo <= (k) && (k) < hi)
#define SEAM(k) do { if (IN(k) && IN((k) + 1)) xcd_barrier(bar); } while (0)
    unsigned char* ws = F.ws;
    const int bx = (int)blockIdx.x;

#define RUN(k, BODY) do { if (IN(k)) { BODY; if (DUP_PHASE == (k)) { xcd_barrier(bar); BODY; } } SEAM(k); } while (0)
#define RUND(k, DRYBODY, BODY) do { if (IN(k)) { if (DUP_PHASE == (k)) { DRYBODY; xcd_barrier(bar); } BODY; } SEAM(k); } while (0)
    RUN(0, p0_prologue(F));
    RUN(1, ({ ProbInProj P; P.A = (const bf16*)(ws + WS_XN); P.Bt = (const bf16*)(ws + WS_WIN); P.K = D; P.Z = (bf16*)(ws + WS_Z); P.S.init(T, NIN, F.G, bx);
        pg8::gemm_phase<ProbInProj, true>(F.lds, P); }));
    RUN(2, p2_mixer(F));
    RUN(3, ({ ProbOutProj P; P.A = (const bf16*)(ws + WS_Y); P.Bt = (const bf16*)(ws + WS_WOUT); P.K = D; P.x = F.in[0]; P.out = F.out; P.S.init(T, D, F.G, bx);
        pg8::gemm_phase<ProbOutProj, true>(F.lds, P); }));
    RUND(4, p4_route(F, true), p4_route(F));
    RUN(5, ({ build_tables(F);
        ProbGateUp P; P.A = (const bf16*)(ws + WS_XN); P.Bt = (const bf16*)(ws + WS_WGU); P.K = D; P.pinfo = (const PInfo*)(ws + WS_PINFO); P.Hid = (bf16*)(ws + WS_Y);
        P.S.tab = (const LAS int*)(F.lds + TAB_OFF); P.S.G = F.G; P.S.c = F.vcu;
        pg8::gemm_phase<ProbGateUp, true>(F.lds, P); }));
    RUN(6, ({ build_tables(F);
        ProbDown P; P.A = (const bf16*)(ws + WS_Y); P.Bt = (const bf16*)(ws + WS_WDN); P.K = FE; P.pinfo = (const PInfo*)(ws + WS_PINFO); P.Yp = (bf16*)(ws + WS_Z);
        P.S.tab = (const LAS int*)(F.lds + TAB_OFF); P.S.G = F.G; P.S.c = F.vcu;
        pg8::gemm_phase<ProbDown, true>(F.lds, P); }));
    RUND(7, p7_combine(F, true), p7_combine(F));
    RUN(8, ({ ProbPP P; P.A = (const bf16*)(ws + WS_PBF); P.Bt = (const bf16*)(ws + WS_WPP); P.K = PLE; P.O = (bf16*)(ws + WS_Y); P.S.init(T, D, F.G, bx);
        pg8::gemm_phase<ProbPP, true>(F.lds, P); }));
    RUND(9, ({ ProbPleGate P; P.A = (const bf16*)(ws + WS_XN); P.Bt = (const bf16*)(ws + WS_WPG); P.K = D; P.PP = (const bf16*)(ws + WS_Y); P.rstd = (const float*)(ws + WS_RSTD); P.out = F.out; P.outw = (float*)(ws + WS_Z); P.S.init(T, D, F.G, bx);
        pg8::gemm_phase<ProbPleGate, true>(F.lds, P); }),
      ({ ProbPleGate P; P.A = (const bf16*)(ws + WS_XN); P.Bt = (const bf16*)(ws + WS_WPG); P.K = D; P.PP = (const bf16*)(ws + WS_Y); P.rstd = (const float*)(ws + WS_RSTD); P.out = F.out; P.outw = F.out; P.S.init(T, D, F.G, bx);
        pg8::gemm_phase<ProbPleGate, true>(F.lds, P); }));
    RUND(10, p10_final(F, true), p10_final(F));
#undef RUN
#undef RUND
#undef IN
#undef SEAM
}

extern "C" void kernel_launch(void* const* d_in, const int* in_sizes, int n_in, void* d_out, int out_size, void* d_ws, size_t ws_size, hipStream_t stream) {
    static int grid = 0;
    if (grid == 0) {
        if (n_in != 21 || in_sizes[0] != T * D || out_size != T * D || ws_size < WS_END) { fprintf(stderr, "kernel_launch: unexpected shapes (n_in %d, in0 %d, out %d, ws %zu)\n", n_in, n_in > 0 ? in_sizes[0] : -1, out_size, ws_size); grid = -1; return; }
        int dev = 0, cus = 0, per_cu = 0;
        if (hipGetDevice(&dev) != hipSuccess || hipDeviceGetAttribute(&cus, hipDeviceAttributeMultiprocessorCount, dev) != hipSuccess) { grid = -1; return; }
        if (hipFuncSetAttribute((const void*)fwd_kernel, hipFuncAttributeMaxDynamicSharedMemorySize, LDS_BYTES) != hipSuccess) { fprintf(stderr, "kernel_launch: hipFuncSetAttribute failed\n"); grid = -1; return; }
        if (hipOccupancyMaxActiveBlocksPerMultiprocessor(&per_cu, (const void*)fwd_kernel, NTHR, LDS_BYTES) != hipSuccess || per_cu < 1) fprintf(stderr, "kernel_launch: occupancy query reports %d blocks per CU\n", per_cu);
        (void)hipGetLastError();
        grid = cus;
    }
    if (grid < 0) return;
    (void)hipMemsetAsync((char*)d_ws + WS_CTL, 0, CTL_ZERO_BYTES, stream);
    Args a{};
    for (int i = 0; i < 21; ++i) a.in[i] = (const float*)d_in[i];
    a.out = (float*)d_out; a.ws = (unsigned char*)d_ws;
#if MK_ONE_LAUNCH
    a.ph_lo = 0; a.ph_hi = N_PHASES; a.li = 0;
    hipLaunchKernelGGL(fwd_kernel, dim3(grid), dim3(NTHR), LDS_BYTES, stream, a);
#else
    for (int li = 0; li < N_PHASES; ++li) { a.ph_lo = li; a.ph_hi = li + 1; a.li = li; hipLaunchKernelGGL(fwd_kernel, dim3(grid), dim3(NTHR), LDS_BYTES, stream, a); }
#endif
}
```
